# Optimizing an MI355X kernel written in HIP

```python
import jax, jax.numpy as jnp
from jax import lax
import numpy as np

D_MODEL = 1024
BATCH = 1
SEQ = 16384
DEPTH = 4

N_META = 16
D_MIX = D_MODEL
CONV_CH = D_MIX // 2
CONV_GROUPS = 8
CONV_WIDTH = 31
DN_HEADS = 4
DN_HEAD_DIM = 128
DN_KEY = DN_HEADS * DN_HEAD_DIM
DN_VAL = DN_HEADS * DN_HEAD_DIM
DN_SHORT_CONV = 4
CHUNK = 64
D_FF = -(-8 * D_MODEL // (3 * 256)) * 256
IN_SIZES = [CONV_CH, CONV_CH, DN_KEY, DN_KEY, DN_VAL, DN_VAL, DN_HEADS, DN_HEADS]
D_IN = sum(IN_SIZES)
IN_SPLITS = [int(s) for s in np.cumsum(IN_SIZES)[:-1]]
NORM_EPS = 1e-6
LN_EPS = 1e-5

kernel_name = "hymba_conformer_gated_deltanet_hybrid"


def rmsnorm(x, w, eps=NORM_EPS):
    xf = x.astype(jnp.float32)
    y = xf * lax.rsqrt(jnp.mean(xf * xf, axis=-1, keepdims=True) + eps)
    return (y * w.astype(jnp.float32)).astype(x.dtype)


def layernorm(x, w, b, eps=LN_EPS):
    xf = x.astype(jnp.float32)
    mu = jnp.mean(xf, axis=-1, keepdims=True)
    var = jnp.mean(jnp.square(xf - mu), axis=-1, keepdims=True)
    y = (xf - mu) * lax.rsqrt(var + eps) * w.astype(jnp.float32) + b.astype(jnp.float32)
    return y.astype(x.dtype)


def l2norm(x, eps=1e-6):
    return x * lax.rsqrt(jnp.sum(x * x, axis=-1, keepdims=True) + eps)


def causal_depthwise_conv(x, w):
    K, C = w.shape
    xp = jnp.pad(x, ((0, 0), (K - 1, 0), (0, 0)))
    return lax.conv_general_dilated(xp, w[:, None, :].astype(x.dtype), window_strides=(1,), padding='VALID',
                                    dimension_numbers=('NWC', 'WIO', 'NWC'), feature_group_count=C)


def conformer_conv_module(h_val, h_gate, dw_w, dw_b, ln_w, ln_b):
    u = h_val * jax.nn.sigmoid(h_gate)
    u = causal_depthwise_conv(u, dw_w) + dw_b
    u = layernorm(u, ln_w, ln_b)
    return jax.nn.silu(u)


def chunk_gated_delta_rule(q, k, v, g, beta):
    Bsz, L, H, dk = k.shape
    dv = v.shape[-1]
    front = CHUNK - N_META
    back = (-(L + front)) % CHUNK

    def to_chunks(t):
        t = jnp.pad(t, [(0, 0), (front, back)] + [(0, 0)] * (t.ndim - 2))
        t = jnp.moveaxis(t, 2, 1)
        return t.reshape((Bsz, H, -1, CHUNK) + t.shape[3:])

    q, k, v, g, beta = (to_chunks(t) for t in (q, k, v, g, beta))
    g = jnp.cumsum(g, axis=-1)
    causal = jnp.tril(jnp.ones((CHUNK, CHUNK), dtype=bool))
    strict = jnp.tril(jnp.ones((CHUNK, CHUNK), dtype=bool), -1)
    decay = jnp.exp(jnp.where(causal, g[..., :, None] - g[..., None, :], -jnp.inf))

    k_beta = k * beta[..., None]
    v_beta = v * beta[..., None]
    lower = jnp.where(strict, jnp.einsum('bhncd,bhnsd->bhncs', k_beta, k) * decay, 0.0)
    a_mat = lower + jnp.eye(CHUNK, dtype=lower.dtype)
    solve = lambda rhs: lax.linalg.triangular_solve(a_mat, rhs, left_side=True, lower=True, unit_diagonal=True)
    u = solve(v_beta)
    w = solve(k_beta * jnp.exp(g)[..., None])

    attn_intra = jnp.where(causal, jnp.einsum('bhncd,bhnsd->bhncs', q, k) * decay, 0.0)
    q_dec = q * jnp.exp(g)[..., None]
    k_dec = k * jnp.exp(g[..., -1:] - g)[..., None]
    g_last = jnp.exp(g[..., -1])

    def step(S, xs):
        q_i, k_i, u_i, w_i, a_i, gl_i = xs
        v_new = u_i - jnp.einsum('bhcd,bhdv->bhcv', w_i, S)
        o_i = jnp.einsum('bhcd,bhdv->bhcv', q_i, S) + jnp.einsum('bhcs,bhsv->bhcv', a_i, v_new)
        S = S * gl_i[..., None, None] + jnp.einsum('bhcd,bhcv->bhdv', k_i, v_new)
        return S, o_i

    xs = (jnp.moveaxis(q_dec, 2, 0), jnp.moveaxis(k_dec, 2, 0), jnp.moveaxis(u, 2, 0),
          jnp.moveaxis(w, 2, 0), jnp.moveaxis(attn_intra, 2, 0), jnp.moveaxis(g_last, 2, 0))
    S0 = jnp.zeros((Bsz, H, dk, dv), jnp.float32)
    _, o = lax.scan(step, S0, xs)
    o = jnp.transpose(o, (1, 0, 3, 2, 4)).reshape(Bsz, -1, H, dv)
    return o[:, front:front + L]


def gated_deltanet(q, k, v, z, b, a, conv_w, A_log, dt_bias, norm_w):
    Bsz, L, _ = q.shape
    dtype = v.dtype
    qkv = jax.nn.silu(causal_depthwise_conv(jnp.concatenate([q, k, v], axis=-1), conv_w))
    q, k, v = jnp.split(qkv.astype(jnp.float32), [DN_KEY, 2 * DN_KEY], axis=-1)
    q = l2norm(q.reshape(Bsz, L, DN_HEADS, DN_HEAD_DIM)) * (DN_HEAD_DIM ** -0.5)
    k = l2norm(k.reshape(Bsz, L, DN_HEADS, DN_HEAD_DIM))
    v = v.reshape(Bsz, L, DN_HEADS, DN_HEAD_DIM)
    beta = jax.nn.sigmoid(b.astype(jnp.float32))
    g = -jnp.exp(A_log.astype(jnp.float32)) * jax.nn.softplus(a.astype(jnp.float32) + dt_bias.astype(jnp.float32))
    o = chunk_gated_delta_rule(q, k, v, g, beta)
    o = o * lax.rsqrt(jnp.mean(o * o, axis=-1, keepdims=True) + NORM_EPS) * norm_w.astype(jnp.float32)
    o = o * jax.nn.silu(z.astype(jnp.float32).reshape(Bsz, L, DN_HEADS, DN_HEAD_DIM))
    return o.reshape(Bsz, L, DN_VAL).astype(dtype)


def setup_inputs(seed: int = 0) -> dict:
    key = jax.random.key(seed)
    ks = jax.random.split(key, 20)
    f = jnp.float32
    nrm = lambda k_, shape: jax.random.normal(k_, shape, f)
    dt = jnp.exp(jax.random.uniform(ks[10], (DEPTH, DN_HEADS), f, np.log(1e-3), np.log(1e-1)))
    return {
        "x": nrm(ks[0], (BATCH, SEQ, D_MODEL)),
        "meta_tokens": nrm(ks[1], (N_META, D_MODEL)),
        "norm_mix_w": 1.0 + 0.02 * nrm(ks[2], (DEPTH, D_MODEL)),
        "w_in": nrm(ks[3], (DEPTH, D_MODEL, D_IN)) * D_MODEL ** -0.5,
        "conv_dw_w": nrm(ks[4], (DEPTH, CONV_WIDTH, CONV_CH)) * CONV_WIDTH ** -0.5,
        "conv_dw_b": 0.02 * nrm(ks[5], (DEPTH, CONV_CH)),
        "conv_ln_w": 1.0 + 0.02 * nrm(ks[6], (DEPTH, CONV_CH)),
        "conv_ln_b": 0.02 * nrm(ks[7], (DEPTH, CONV_CH)),
        "dn_conv_w": nrm(ks[8], (DEPTH, DN_SHORT_CONV, 2 * DN_KEY + DN_VAL)) * DN_SHORT_CONV ** -0.5,
        "dn_A_log": jnp.log(jax.random.uniform(ks[9], (DEPTH, DN_HEADS), f, 1.0, 16.0)),
        "dn_dt_bias": dt + jnp.log(-jnp.expm1(-dt)),
        "dn_norm_w": 1.0 + 0.02 * nrm(ks[11], (DEPTH, DN_HEAD_DIM)),
        "w_out": nrm(ks[12], (DEPTH, D_MIX, D_MODEL)) * D_MIX ** -0.5,
        "norm_ffn_w": 1.0 + 0.02 * nrm(ks[13], (DEPTH, D_MODEL)),
        "ffn_w_gu": nrm(ks[14], (DEPTH, D_MODEL, 2 * D_FF)) * D_MODEL ** -0.5,
        "ffn_w_down": nrm(ks[15], (DEPTH, D_FF, D_MODEL)) * D_FF ** -0.5,
        "final_norm_w": 1.0 + 0.02 * nrm(ks[16], (D_MODEL,)),
    }


def reference(x, meta_tokens, norm_mix_w, w_in, conv_dw_w, conv_dw_b, conv_ln_w, conv_ln_b,
              dn_conv_w, dn_A_log, dn_dt_bias, dn_norm_w, w_out, norm_ffn_w, ffn_w_gu, ffn_w_down,
              final_norm_w):
    Bsz = x.shape[0]
    meta = jnp.broadcast_to(meta_tokens[None].astype(x.dtype), (Bsz, N_META, D_MODEL))
    h = jnp.concatenate([meta, x], axis=1)
    for l in range(DEPTH):
        hn = rmsnorm(h, norm_mix_w[l])
        proj = jnp.einsum('bld,de->ble', hn, w_in[l])
        c_val, c_gate, q, k, v, z, b, a = jnp.split(proj, IN_SPLITS, axis=-1)
        y_conv = conformer_conv_module(c_val, c_gate, conv_dw_w[l], conv_dw_b[l], conv_ln_w[l], conv_ln_b[l])
        y_dn = gated_deltanet(q, k, v, z, b, a, dn_conv_w[l], dn_A_log[l], dn_dt_bias[l], dn_norm_w[l])
        y = jnp.concatenate([y_conv, y_dn], axis=-1)
        h = h + jnp.einsum('ble,ed->bld', y, w_out[l])
        hn = rmsnorm(h, norm_ffn_w[l])
        gate, up = jnp.split(jnp.einsum('bld,df->blf', hn, ffn_w_gu[l]), 2, axis=-1)
        h = h + jnp.einsum('blf,fd->bld', jax.nn.silu(gate) * up, ffn_w_down[l])
    out = rmsnorm(h, final_norm_w)
    return out[:, N_META:]
```

```cpp
#include <hip/hip_runtime.h>
#include <hip/hip_cooperative_groups.h>
#include <cstdio>
#include <cstdint>
namespace cg = cooperative_groups;
namespace pg8 {
#define PG8_LAS __attribute__((address_space(3)))
typedef unsigned short bf16_t;
typedef short bf16x8 __attribute__((ext_vector_type(8)));
typedef float f32x4 __attribute__((ext_vector_type(4)));
typedef unsigned u32x4 __attribute__((ext_vector_type(4)));
constexpr int BM = 256, BK = 64, HALF = 128, HTB = HALF * BK * 2  , STAGE_BYTES = 8 * HTB, NXCD = 8, WGM = 8;

__host__ __device__ __forceinline__ int lds_byte(int r, int c) { const int st = (r >> 4) * 2 + (c >> 5), rr = r & 15, cc = c & 31, ob = rr * 64 + cc * 2; return st * 1024 + (ob ^ (((ob >> 9) & 1) << 5)); }
__host__ __device__ __forceinline__ void stage_rc(int b, int& R, int& C) { const int st = b / 1024, sb = b % 1024, swz = sb ^ (((sb >> 9) & 1) << 5); R = (st >> 1) * 16 + swz / 64; C = (st & 1) * 32 + (swz % 64) / 2; }
__host__ __device__ __forceinline__ int perm32(int rho) { const int n = rho >> 4, i = rho & 15; return 8 * (i >> 2) + 4 * n + (i & 3); }

struct Unit { int pm, pn, idx; };
struct Gemm { const bf16_t* A; const bf16_t* Bt; int M, N, K; };

struct StaticOrder {
    int nM, nN, nwg, G, c;
    __host__ __device__ void init(int M, int N, int G_, int c_) { nM = M / BM; nN = N / BM; nwg = nM * nN; G = G_; c = c_; }
    __host__ __device__ bool next(int i, Unit& u) const {
        const long L = (long)i * G + c; if (L >= nwg) return false;
        int wgid = (int)L; { const int q = nwg / NXCD, r = nwg % NXCD, xcd = wgid % NXCD, off = wgid / NXCD; wgid = (xcd < r ? xcd * (q + 1) : r * (q + 1) + (xcd - r) * q) + off; }
        const int nig = WGM * nN, gid = wgid / nig, fm = gid * WGM, gsz = (nM - fm) < WGM ? (nM - fm) : WGM;
        u.pm = fm + ((wgid % nig) % gsz); u.pn = (wgid % nig) / gsz; u.idx = i; return true;
    }
    __device__ __forceinline__ void a_ready(const Unit&) const {}
    __device__ __forceinline__ void done(const Unit&) const {}
};

__device__ __forceinline__ unsigned cvt_pk_bf16(float lo, float hi) { unsigned r; asm volatile("v_cvt_pk_bf16_f32 %0, %1, %2" : "=v"(r) : "v"(lo), "v"(hi)); return r; }
typedef float f32x2 __attribute__((ext_vector_type(2)));
typedef unsigned u32x2e __attribute__((ext_vector_type(2)));
struct EpiProj {
    static constexpr bool PERM = true, AFTER_DRAIN = false;
    bf16_t* O; int ldc; const PG8_LAS float* rs;
    __device__ __forceinline__ void operator()(const f32x4 (&acc)[2][2][4][2], const Unit& u, int wr, int wc, int fr, int fq) const {
        const int rl0 = wr * 64 + fr, col0 = u.pn * BM + wc * 32 + 8 * fq;
#pragma unroll
        for (int ai = 0; ai < 2; ++ai)
#pragma unroll
            for (int m = 0; m < 4; ++m) { const int rl = rl0 + ai * HALF + m * 16; const float s = rs[u.idx * 256 + rl];
                bf16_t* rowp = O + (size_t)(u.pm * BM + rl) * ldc + col0;
#pragma unroll
                for (int bj = 0; bj < 2; ++bj) { const f32x4 v0 = acc[ai][bj][m][0] * s, v1 = acc[ai][bj][m][1] * s;
                    u32x4 w; w.x = cvt_pk_bf16(v0[0], v0[1]); w.y = cvt_pk_bf16(v0[2], v0[3]); w.z = cvt_pk_bf16(v1[0], v1[1]); w.w = cvt_pk_bf16(v1[2], v1[3]);
                    *(u32x4*)(rowp + bj * HALF) = w; } }
    }
};
struct EpiSwiGLU {
    static constexpr bool PERM = true, AFTER_DRAIN = false;
    bf16_t* O; int ldc; const PG8_LAS float* rs;
    __device__ __forceinline__ void operator()(const f32x4 (&acc)[2][2][4][2], const Unit& u, int wr, int wc, int fr, int fq) const {
        const int rl0 = wr * 64 + fr, col0 = u.pn * HALF + wc * 32 + 8 * fq;
#pragma unroll
        for (int ai = 0; ai < 2; ++ai)
#pragma unroll
            for (int m = 0; m < 4; ++m) { const int rl = rl0 + ai * HALF + m * 16; const float s = rs[u.idx * 256 + rl];
                float o[8];
#pragma unroll
                for (int n = 0; n < 2; ++n)
#pragma unroll
                    for (int e = 0; e < 4; ++e) { const float g = acc[ai][0][m][n][e] * s, up = acc[ai][1][m][n][e] * s; o[n * 4 + e] = g * __builtin_amdgcn_rcpf(1.f + __expf(-g)) * up; }
                u32x4 w; w.x = cvt_pk_bf16(o[0], o[1]); w.y = cvt_pk_bf16(o[2], o[3]); w.z = cvt_pk_bf16(o[4], o[5]); w.w = cvt_pk_bf16(o[6], o[7]);
                *(u32x4*)(O + (size_t)(u.pm * BM + rl) * ldc + col0) = w; }
    }
};
struct EpiResid {
    static constexpr bool PERM = true, AFTER_DRAIN = false;
    float* hmain; float* hmeta; bf16_t* hb; float* ssq;
    __device__ __forceinline__ void operator()(const f32x4 (&acc)[2][2][4][2], const Unit& u, int wr, int wc, int fr, int fq) const {
        float* hbase = (u.pm < 64) ? hmain : hmeta - (size_t)16384 * 1024;
        const int col0 = u.pn * BM + wc * 32 + 8 * fq;
#pragma unroll
        for (int ai = 0; ai < 2; ++ai)
#pragma unroll
            for (int m = 0; m < 4; ++m) { const int row = u.pm * BM + ai * HALF + wr * 64 + m * 16 + fr; float sq = 0.f;
#pragma unroll
                for (int bj = 0; bj < 2; ++bj) { const size_t off = (size_t)row * 1024 + col0 + bj * HALF;
                    f32x4 h0 = *(const f32x4*)(hbase + off), h1 = *(const f32x4*)(hbase + off + 4);
                    h0 = h0 + acc[ai][bj][m][0]; h1 = h1 + acc[ai][bj][m][1]; *(f32x4*)(hbase + off) = h0; *(f32x4*)(hbase + off + 4) = h1;
                    sq += ((h0[0] * h0[0] + h0[1] * h0[1]) + (h0[2] * h0[2] + h0[3] * h0[3])) + ((h1[0] * h1[0] + h1[1] * h1[1]) + (h1[2] * h1[2] + h1[3] * h1[3]));
                    u32x4 w; w.x = cvt_pk_bf16(h0[0], h0[1]); w.y = cvt_pk_bf16(h0[2], h0[3]); w.z = cvt_pk_bf16(h1[0], h1[1]); w.w = cvt_pk_bf16(h1[2], h1[3]); *(u32x4*)(hb + off) = w; }
                sq += __shfl_xor(sq, 16); sq += __shfl_xor(sq, 32);
                if (fq == 0) ssq[(size_t)row * 16 + u.pn * 4 + wc] = sq; }
    }
};

template <class Epi, class Sched, bool ALIGN_EPI = false, bool SP2 = false>
__device__ __forceinline__ void gemm_phase(PG8_LAS unsigned char* lds, const Gemm g, const Sched& S, const Epi& E) {
    int tid_ = threadIdx.x; asm volatile("" : "+v"(tid_)); const int tid = tid_, wid = __builtin_amdgcn_readfirstlane(tid >> 6), lane = tid & 63, wr = wid >> 2, wc = wid & 3, fr = lane & 15, fq = lane >> 4;
    const int K = g.K, nt = K / BK;
    unsigned voffA[2], voffB[2];
#pragma unroll
    for (int i = 0; i < 2; ++i) { int R, C; stage_rc(tid * 16 + i * 8192, R, C); const int Rb = Epi::PERM ? ((R & ~31) + perm32(R & 31)) : R;
        voffA[i] = (unsigned)(R * K + C) * 2u; voffB[i] = (unsigned)(Rb * K + C) * 2u; }
    const size_t kstep = (size_t)(BK * 2);
    const size_t hstep = (size_t)HALF * K * 2;
    const size_t tstep = 2 * hstep;
    const unsigned ldsw = (unsigned)wid * 1024u;
    const int aoff = lds_byte(wr * 64 + fr, fq * 8), boff = lds_byte(wc * 32 + fr, fq * 8);
#define PG8_SA(b, h) (((b) * 2 + (h)) * HTB)
#define PG8_SB(b, h) ((4 + (b) * 2 + (h)) * HTB)
#define PG8_STAGE(bufoff, gbase, voff) do { _Pragma("unroll") for (int _i = 0; _i < 2; ++_i) \
        __builtin_amdgcn_global_load_lds((const unsigned*)((const char*)(gbase) + (voff)[_i]), (PG8_LAS unsigned*)(lds + (bufoff) + ldsw + _i * 8192), 16, 0, 0); } while (0)
#define PG8_LDA(dst, b, h) do { _Pragma("unroll") for (int m = 0; m < 4; ++m) _Pragma("unroll") for (int k = 0; k < 2; ++k) dst[m][k] = *(const PG8_LAS bf16x8*)(lds + PG8_SA(b, h) + aoff + m * 2048 + k * 1024); } while (0)
#define PG8_LDB(dst, b, h) do { _Pragma("unroll") for (int n = 0; n < 2; ++n) _Pragma("unroll") for (int k = 0; k < 2; ++k) dst[n][k] = *(const PG8_LAS bf16x8*)(lds + PG8_SB(b, h) + boff + n * 2048 + k * 1024); } while (0)
#define PG8_MMA(ai, bj, At, Bt) do { __builtin_amdgcn_s_setprio(1); _Pragma("unroll") for (int m = 0; m < 4; ++m) _Pragma("unroll") for (int n = 0; n < 2; ++n) _Pragma("unroll") for (int k = 0; k < 2; ++k) \
        acc[ai][bj][m][n] = __builtin_amdgcn_mfma_f32_16x16x32_bf16(Bt[n][k], At[m][k], acc[ai][bj][m][n], 0, 0, 0); __builtin_amdgcn_s_setprio(0); } while (0)
#define PG8_WAIT_V(n) asm volatile("s_waitcnt vmcnt(" #n ")" ::: "memory")
#define PG8_WAIT_L(n) asm volatile("s_waitcnt lgkmcnt(" #n ")" ::: "memory")
#define PG8_BAR __builtin_amdgcn_s_barrier()
#define PG8_SCHED __builtin_amdgcn_sched_barrier(0)
    Unit cur, nxt; int ui = 0;
    if (!S.next(0, cur)) return;
    f32x4 acc[2][2][4][2];
#pragma unroll
    for (int a = 0; a < 2; ++a)
#pragma unroll
        for (int b = 0; b < 2; ++b)
#pragma unroll
            for (int m = 0; m < 4; ++m)
#pragma unroll
                for (int n = 0; n < 2; ++n) acc[a][b][m][n] = (f32x4){0.f, 0.f, 0.f, 0.f};
    bf16x8 At[4][2], B0[2][2], B1[2][2];
    const char* cA = (const char*)g.A + (size_t)cur.pm * tstep; const char* cB = (const char*)g.Bt + (size_t)cur.pn * tstep;
    S.a_ready(cur);
    if constexpr (SP2) {
        PG8_STAGE(PG8_SB(0, 0), cB, voffB); PG8_STAGE(PG8_SB(0, 1), cB + hstep, voffB); PG8_STAGE(PG8_SA(0, 0), cA, voffA); PG8_STAGE(PG8_SA(0, 1), cA + hstep, voffA);
        if (wr == 1) PG8_BAR;
        PG8_WAIT_V(2); PG8_BAR;
        PG8_STAGE(PG8_SB(1, 0), cB + kstep, voffB); PG8_STAGE(PG8_SA(1, 0), cA + kstep, voffA); PG8_STAGE(PG8_SB(1, 1), cB + hstep + kstep, voffB);
        PG8_WAIT_V(6); PG8_BAR;
    } else {
        PG8_STAGE(PG8_SB(0, 0), cB, voffB); PG8_STAGE(PG8_SA(0, 0), cA, voffA); PG8_STAGE(PG8_SB(0, 1), cB + hstep, voffB); PG8_STAGE(PG8_SA(0, 1), cA + hstep, voffA);
        if (wr == 1) PG8_BAR;
        PG8_WAIT_V(4); PG8_BAR;
        PG8_STAGE(PG8_SB(1, 0), cB + kstep, voffB); PG8_STAGE(PG8_SA(1, 0), cA + kstep, voffA); PG8_STAGE(PG8_SB(1, 1), cB + hstep + kstep, voffB);
        PG8_WAIT_V(6); PG8_BAR;
    }
    for (;;) {
        const bool has_next = S.next(ui + 1, nxt);
        const char* nA = has_next ? (const char*)g.A + (size_t)nxt.pm * tstep : cA; const char* nB = has_next ? (const char*)g.Bt + (size_t)nxt.pn * tstep : cB;
        for (int t = 0; t < nt; t += 2) {
            const bool last = (t == nt - 2);
            const char* a1 = cA + (size_t)(t + 1) * kstep;
            const char* a2 = last ? nA : cA + (size_t)(t + 2) * kstep; const char* b2 = last ? nB : cB + (size_t)(t + 2) * kstep;
            const char* a3 = a2 + kstep; const char* b3 = b2 + kstep;
            if (last && has_next) S.a_ready(nxt);
            if constexpr (SP2) {
            PG8_LDB(B0, 0, 0); PG8_LDB(B1, 0, 1); PG8_SCHED; PG8_LDA(At, 0, 0); PG8_STAGE(PG8_SA(1, 1), a1 + hstep, voffA);
            PG8_WAIT_V(8); PG8_WAIT_L(0); PG8_BAR; PG8_MMA(0, 0, At, B0); PG8_MMA(0, 1, At, B1); PG8_BAR; PG8_SCHED;
            PG8_LDA(At, 0, 1); PG8_STAGE(PG8_SB(0, 0), b2, voffB); PG8_STAGE(PG8_SB(0, 1), b2 + hstep, voffB); PG8_STAGE(PG8_SA(0, 0), a2, voffA);
            PG8_WAIT_V(8); PG8_WAIT_L(0); PG8_BAR; PG8_MMA(1, 0, At, B0); PG8_MMA(1, 1, At, B1); PG8_BAR; PG8_SCHED;
            PG8_LDB(B0, 1, 0); PG8_LDB(B1, 1, 1); PG8_SCHED; PG8_LDA(At, 1, 0); PG8_STAGE(PG8_SA(0, 1), a2 + hstep, voffA);
            PG8_WAIT_V(8); PG8_WAIT_L(0); PG8_BAR; PG8_MMA(0, 0, At, B0); PG8_MMA(0, 1, At, B1); PG8_BAR; PG8_SCHED;
            PG8_LDA(At, 1, 1); PG8_STAGE(PG8_SB(1, 0), b3, voffB); PG8_STAGE(PG8_SB(1, 1), b3 + hstep, voffB); PG8_STAGE(PG8_SA(1, 0), a3, voffA);
            PG8_WAIT_V(8); PG8_WAIT_L(0); PG8_BAR; PG8_MMA(1, 0, At, B0); PG8_MMA(1, 1, At, B1); PG8_BAR; PG8_SCHED;
            } else {
            PG8_LDB(B0, 0, 0); PG8_SCHED; PG8_LDA(At, 0, 0); PG8_STAGE(PG8_SA(1, 1), a1 + hstep, voffA);
            PG8_WAIT_L(8); PG8_BAR; PG8_WAIT_L(0); PG8_MMA(0, 0, At, B0); PG8_BAR; PG8_SCHED;
            PG8_LDB(B1, 0, 1); PG8_STAGE(PG8_SB(0, 0), b2, voffB);
            PG8_BAR; PG8_WAIT_L(0); PG8_MMA(0, 1, At, B1); PG8_BAR;
            PG8_LDA(At, 0, 1); PG8_STAGE(PG8_SA(0, 0), a2, voffA);
            PG8_BAR; PG8_WAIT_L(0); PG8_MMA(1, 0, At, B0); PG8_BAR; PG8_SCHED;
            PG8_STAGE(PG8_SB(0, 1), b2 + hstep, voffB);
            PG8_WAIT_V(6); PG8_BAR; PG8_MMA(1, 1, At, B1); PG8_BAR;
            PG8_LDB(B0, 1, 0); PG8_SCHED; PG8_LDA(At, 1, 0); PG8_STAGE(PG8_SA(0, 1), a2 + hstep, voffA);
            PG8_WAIT_L(8); PG8_BAR; PG8_WAIT_L(0); PG8_MMA(0, 0, At, B0); PG8_BAR; PG8_SCHED;
            PG8_LDB(B1, 1, 1); PG8_STAGE(PG8_SB(1, 0), b3, voffB);
            PG8_BAR; PG8_WAIT_L(0); PG8_MMA(0, 1, At, B1); PG8_BAR;
            PG8_LDA(At, 1, 1); PG8_STAGE(PG8_SA(1, 0), a3, voffA);
            PG8_BAR; PG8_WAIT_L(0); PG8_MMA(1, 0, At, B0); PG8_BAR; PG8_SCHED;
            PG8_STAGE(PG8_SB(1, 1), b3 + hstep, voffB);
            PG8_WAIT_V(6); PG8_BAR; PG8_MMA(1, 1, At, B1); PG8_BAR;
            }
        }
        if constexpr (ALIGN_EPI) { if (wr == 0) PG8_BAR; }
        if constexpr (!Epi::AFTER_DRAIN) { E(acc, cur, wr, wc, fr, fq); S.done(cur); }
        if (!has_next) break;
#pragma unroll
        for (int a = 0; a < 2; ++a)
#pragma unroll
            for (int b = 0; b < 2; ++b)
#pragma unroll
                for (int m = 0; m < 4; ++m)
#pragma unroll
                    for (int n = 0; n < 2; ++n) acc[a][b][m][n] = (f32x4){0.f, 0.f, 0.f, 0.f};
        cur = nxt; cA = nA; cB = nB; ++ui;
        if constexpr (ALIGN_EPI) { if (wr == 1) PG8_BAR; }
    }
    PG8_WAIT_V(0);
    if constexpr (!ALIGN_EPI) { if (wr == 0) PG8_BAR; }
    PG8_BAR;
    if constexpr (Epi::AFTER_DRAIN) { E.fused(acc, cur, wr, wc, fr, fq, lds, wid, lane); S.done(cur); }
#undef PG8_SA
#undef PG8_SB
#undef PG8_STAGE
#undef PG8_LDA
#undef PG8_LDB
#undef PG8_MMA
#undef PG8_WAIT_V
#undef PG8_WAIT_L
#undef PG8_BAR
#undef PG8_SCHED
}
}
#define LAS __attribute__((address_space(3)))
typedef unsigned short bf16;
typedef short bf16x8 __attribute__((ext_vector_type(8)));
typedef float f32x4 __attribute__((ext_vector_type(4)));
typedef unsigned u32x4 __attribute__((ext_vector_type(4)));
typedef unsigned u32x2 __attribute__((ext_vector_type(2)));

constexpr int DM = 1024, SEQ = 16384, LTOK = 16400, RPAD = 16640, DEPTH = 4;
constexpr int NPROJ = 3072, DIN = 3080, DFF = 2816, NGU = 5632;
constexpr int NTASK = 1028;
constexpr int NSCAN = 32;
constexpr int CT = 66, NCT = 249;
constexpr size_t MiB = 1u << 20;
constexpr size_t WS_WBA = 1 * MiB, WS_GL = 1 * MiB + 256 * 1024, WS_SSQ = 2 * MiB, WS_HMETA = 3 * MiB + 512 * 1024;
constexpr size_t WS_WIN = 5 * MiB, WS_WOUT = 11 * MiB, WS_WGU = 13 * MiB, WS_WDN = 24 * MiB, WS_HB = 30 * MiB, WS_PROJ = 63 * MiB;
constexpr size_t WS_Y = 161 * MiB, WS_MP = 194 * MiB, WS_NL = 227 * MiB, WS_QP = 260 * MiB, WS_O0 = 277 * MiB, WS_SIMG = 294 * MiB, WS_BG = 328 * MiB, WS_MG = 329 * MiB, WS_NG = 332 * MiB, WS_GG = 335 * MiB, WS_WBAB = 336 * MiB, WS_END = 337 * MiB;
constexpr int LDS_BYTES = 147456, RS_OFF = 131072 + 512;

struct Params { const float* in[17]; float* out; unsigned char* ws; };
typedef const __attribute__((address_space(4))) Params* KP;
__device__ __forceinline__ Params load_params(KP kp) {
    Params P{};
#if defined(__HIP_DEVICE_COMPILE__)
    asm volatile("" : "+s"(kp));
#pragma unroll
    for (int i = 0; i < 17; ++i) P.in[i] = kp->in[i];
    P.out = kp->out; P.ws = kp->ws;
#endif
    return P;
}
#define LOAD_PARAMS(kp) const Params P = load_params(kp)

__device__ __forceinline__ int bidx() { int b = blockIdx.x; asm volatile("" : "+s"(b)); return b; }
constexpr int GRID = 256;
__device__ __forceinline__ float bf2f(unsigned v) { return __uint_as_float(v << 16); }
__device__ __forceinline__ float bflo(unsigned v) { return __uint_as_float(v << 16); }
__device__ __forceinline__ float bfhi(unsigned v) { return __uint_as_float(v & 0xffff0000u); }
typedef __bf16 bf16x2_t __attribute__((ext_vector_type(2)));
__device__ __forceinline__ unsigned pk2(float lo, float hi) { bf16x2_t v = {(__bf16)lo, (__bf16)hi}; return __builtin_bit_cast(unsigned, v); }
__device__ __forceinline__ unsigned f2bf(float f) { return pk2(f, f) & 0xffffu; }
__device__ __forceinline__ f32x4 mfma16(bf16x8 a, bf16x8 b, f32x4 c) { return __builtin_amdgcn_mfma_f32_16x16x32_bf16(a, b, c, 0, 0, 0); }
__device__ __forceinline__ float sigm(float x) { return __builtin_amdgcn_rcpf(1.f + __expf(-x)); }
__device__ __forceinline__ float silu(float x) { return x * sigm(x); }
__device__ __forceinline__ float sum8(float v) { v += __int_as_float(__builtin_amdgcn_update_dpp(0, __float_as_int(v), 0xB1, 0xf, 0xf, false)); v += __int_as_float(__builtin_amdgcn_update_dpp(0, __float_as_int(v), 0x4E, 0xf, 0xf, false));
    v += __int_as_float(__builtin_amdgcn_update_dpp(0, __float_as_int(v), 0x141, 0xf, 0xf, false)); return v; }
__device__ __forceinline__ float wave_sum(float v) {
#pragma unroll
    for (int o = 1; o < 64; o <<= 1) v += __shfl_xor(v, o);
    return v;
}
__device__ __forceinline__ float wave_tr_reduce64(float (&v)[64], int lane) {
#pragma unroll
    for (int off = 32; off >= 1; off >>= 1) {
        const bool hi = (lane & off) != 0;
#pragma unroll
        for (int i = 0; i < off; ++i) {
            const float send = hi ? v[i] : v[i + off];
            const float keep = hi ? v[i + off] : v[i];
            v[i] = keep + __shfl_xor(send, off);
        }
    }
    return v[0];
}
__device__ __forceinline__ int pos_row(int p) { return p < 16 ? SEQ + p : p - 16; }
__device__ __forceinline__ int chunk_row(int c, int tok) { return c == 0 ? (tok < 48 ? -1 : SEQ + tok - 48) : 64 * (c - 1) + tok; }

__device__ __forceinline__ void conv_item(const float* __restrict__ W, int Nsrc, int srccol0, const float* __restrict__ scale, bf16* WT, int K, int drow0, int k0, LAS float* scr, int lane) {
    float wv[32];
#pragma unroll
    for (int i = 0; i < 32; ++i) { const int kk = 2 * i + (lane >> 5); wv[i] = W[(size_t)(k0 + kk) * Nsrc + srccol0 + (lane & 31)]; }
    if (scale) {
#pragma unroll
        for (int i = 0; i < 32; ++i) wv[i] *= scale[k0 + 2 * i + (lane >> 5)]; }
#pragma unroll
    for (int i = 0; i < 32; ++i) { const int kk = 2 * i + (lane >> 5); scr[kk * 33 + (lane & 31)] = wv[i]; }
    asm volatile("s_waitcnt lgkmcnt(0)" ::: "memory");
    const int c = lane & 7;
#pragma unroll
    for (int j = 0; j < 4; ++j) { const int n = (lane >> 3) + 8 * j; const LAS float* s = scr + (8 * c) * 33 + n;
        u32x4 o; o.x = pk2(s[0 * 33], s[1 * 33]); o.y = pk2(s[2 * 33], s[3 * 33]); o.z = pk2(s[4 * 33], s[5 * 33]); o.w = pk2(s[6 * 33], s[7 * 33]);
        *(u32x4*)(WT + (size_t)(drow0 + n) * K + k0 + 8 * c) = o; }
    asm volatile("s_waitcnt lgkmcnt(0)" ::: "memory");
}
__device__ __forceinline__ void conv_weight_items(int kind, int l, const Params& P, LAS float* scr, int gw, int ngw, int lane) {
    unsigned char* ws = P.ws;
    if (kind == 0) { const float* W = P.in[3] + (size_t)l * DM * DIN; const float* sc = P.in[2] + l * DM; bf16* WT = (bf16*)(ws + WS_WIN);
        for (int it = gw; it < 16 * 96; it += ngw) { const int kb = it / 96, nb = it % 96; conv_item(W, DIN, 32 * nb, sc, WT, DM, 32 * nb, 64 * kb, scr, lane); } }
    else if (kind == 1) { const float* W = P.in[12] + (size_t)l * DM * DM; bf16* WT = (bf16*)(ws + WS_WOUT);
        for (int it = gw; it < 16 * 32; it += ngw) { const int kb = it / 32, nb = it % 32; conv_item(W, DM, 32 * nb, nullptr, WT, DM, 32 * nb, 64 * kb, scr, lane); } }
    else if (kind == 2) { const float* W = P.in[14] + (size_t)l * DM * NGU; const float* sc = P.in[13] + l * DM; bf16* WT = (bf16*)(ws + WS_WGU);
        for (int it = gw; it < 16 * 176; it += ngw) { const int kb = it / 176, nb = it % 176; const int d0 = 32 * nb, pn = d0 >> 8, j0 = d0 & 255;
            const int src = j0 < 128 ? 128 * pn + j0 : DFF + 128 * pn + (j0 - 128); conv_item(W, NGU, src, sc, WT, DM, d0, 64 * kb, scr, lane); } }
    else { const float* W = P.in[15] + (size_t)l * DFF * DM; bf16* WT = (bf16*)(ws + WS_WDN);
        for (int it = gw; it < 44 * 32; it += ngw) { const int kb = it / 32, nb = it % 32; conv_item(W, DM, 32 * nb, nullptr, WT, DFF, 32 * nb, 64 * kb, scr, lane); } }
}

template <class Sched> __device__ __forceinline__ void fill_rstd(LAS float* rs, const Sched& S, const float* ssq) {
    LAS int* upm = (LAS int*)(rs + 6 * 256);
    if (threadIdx.x < 6) { pg8::Unit u; upm[threadIdx.x] = S.next((int)threadIdx.x, u) ? u.pm : -1; }
    __syncthreads();
    if (threadIdx.x < 256) { f32x4 v[6][4];
#pragma unroll
        for (int i = 0; i < 6; ++i) { const int pm = upm[i]; const f32x4* p = (const f32x4*)(ssq + (size_t)((pm < 0 ? 0 : pm) * 256 + threadIdx.x) * 16); v[i][0] = p[0]; v[i][1] = p[1]; v[i][2] = p[2]; v[i][3] = p[3]; }
#pragma unroll
        for (int i = 0; i < 6; ++i) { const f32x4 a = v[i][0], b = v[i][1], c = v[i][2], d = v[i][3];
            const float s = ((a[0] + a[1]) + (a[2] + a[3])) + ((b[0] + b[1]) + (b[2] + b[3])) + ((c[0] + c[1]) + (c[2] + c[3])) + ((d[0] + d[1]) + (d[2] + d[3]));
            rs[i * 256 + threadIdx.x] = rsqrtf(s * (1.f / 1024.f) + 1e-6f); } }
    __syncthreads();
}

__device__ __forceinline__ void prologue_phase(LAS unsigned char* lds, KP kp) {
    LOAD_PARAMS(kp);
    int tid_ = threadIdx.x; asm volatile("" : "+v"(tid_)); const int tid = tid_, lane = tid & 63, wave = tid >> 6, gw = bidx() * 8 + wave, ngw = GRID * 8;
    unsigned char* ws = P.ws;
    conv_weight_items(0, 0, P, (LAS float*)(lds + wave * 8448), gw, ngw, lane);
    { float* wba = (float*)(ws + WS_WBA);
      for (int i = bidx() * 512 + tid; i < DEPTH * 8 * DM; i += GRID * 512) { const int l = i >> 13, j = (i >> 10) & 7, k = i & 1023;
          wba[i] = P.in[3][((size_t)l * DM + k) * DIN + NPROJ + j] * P.in[2][l * DM + k]; } }
    { bf16* wbab = (bf16*)(ws + WS_WBAB);
      for (int i = bidx() * 512 + tid; i < DEPTH * 16 * DM; i += GRID * 512) { const int l = i >> 14, j = (i >> 10) & 15, k = i & 1023;
          const float wv = P.in[3][((size_t)l * DM + k) * DIN + NPROJ + (j & 7)] * P.in[2][l * DM + k]; const unsigned hi = f2bf(wv);
          wbab[i] = j < 8 ? (bf16)hi : (bf16)f2bf(wv - bf2f(hi)); } }
    { float* hmeta = (float*)(ws + WS_HMETA); bf16* hb = (bf16*)(ws + WS_HB); float* ssq = (float*)(ws + WS_SSQ);
      for (int row = gw; row < RPAD; row += ngw) {
          const float* src = row < SEQ ? P.in[0] + (size_t)row * DM : (row < LTOK ? P.in[1] + (size_t)(row - SEQ) * DM : nullptr);
          float* dst = row < SEQ ? P.out + (size_t)row * DM : hmeta + (size_t)(row - SEQ) * DM; float s = 0.f;
#pragma unroll
          for (int j = 0; j < 4; ++j) { f32x4 v = {0.f, 0.f, 0.f, 0.f}; if (src) v = ((const f32x4*)src)[lane + 64 * j]; ((f32x4*)dst)[lane + 64 * j] = v;
              s += (v[0] * v[0] + v[1] * v[1]) + (v[2] * v[2] + v[3] * v[3]); u32x2 w; w.x = pk2(v[0], v[1]); w.y = pk2(v[2], v[3]); ((u32x2*)(hb + (size_t)row * DM))[lane + 64 * j] = w; }
          s = wave_sum(s); if (lane < 16) ssq[(size_t)row * 16 + lane] = lane == 0 ? s : 0.f; } }
}

__device__ __forceinline__ void prep_phase(LAS unsigned char* lds, int l, KP kp) {
    LOAD_PARAMS(kp);
    int tid_ = threadIdx.x; asm volatile("" : "+v"(tid_)); const int tid = tid_, lane = tid & 63, wave = tid >> 6, r = lane & 15, q = lane >> 4;
    unsigned char* ws = P.ws;
    const bf16* proj = (const bf16*)(ws + WS_PROJ);
    const float* bg = (const float*)(ws + WS_BG); float* glast = (float*)(ws + WS_GL);
    bf16* Mp = (bf16*)(ws + WS_MP); bf16* Nl = (bf16*)(ws + WS_NL); bf16* Qp = (bf16*)(ws + WS_QP); bf16* O0 = (bf16*)(ws + WS_O0);
    LAS bf16* qs = (LAS bf16*)(lds + 0); LAS bf16* ks = (LAS bf16*)(lds + 17408); LAS bf16* rhsT = (LAS bf16*)(lds + 34816);
    LAS bf16* kdT = (LAS bf16*)(lds + 71680); LAS bf16* uwT = (LAS bf16*)(lds + 90112);
    LAS float* Am = (LAS float*)(lds + 90112); LAS float* TT = (LAS float*)(lds + 107520);
    LAS bf16* Tb = (LAS bf16*)(lds + 126976); LAS bf16* attn = (LAS bf16*)(lds + 136192);
    LAS float* gcs = (LAS float*)(lds + 145408); LAS float* betas = gcs + 64; LAS float* egc = gcs + 128; LAS float* red = gcs + 192; LAS float* redk = gcs + 320;
    for (int task = bidx(); task < NTASK; task += GRID) {
        const int c = task >> 2, h = task & 3;
        const int d = tid & 127, tq = tid >> 7, pbase = 64 * c - 48 + 16 * tq;
        unsigned short raw[3][19];
#pragma unroll
        for (int which = 0; which < 3; ++which)
#pragma unroll
            for (int t = 0; t < 19; ++t) { const int p = pbase + t - 3; raw[which][t] = proj[(size_t)pos_row(p < 0 ? 0 : p) * NPROJ + 1024 + which * 512 + h * 128 + d]; }
        if (wave == 0) { const int row = chunk_row(c, lane); float beta = 0.f, g = 0.f; if (row >= 0) { beta = bg[(size_t)row * 8 + h]; g = bg[(size_t)row * 8 + 4 + h]; }
#pragma unroll
            for (int off = 1; off < 64; off <<= 1) { const float t = __shfl_up(g, off); if (lane >= off) g += t; }
            gcs[lane] = g; egc[lane] = expf(g); betas[lane] = beta; if (lane == 63) glast[task] = expf(g); }
        __syncthreads();
        { const float gl = gcs[63]; float valq[16], valk[16];
#define PB_CONV(which_, val_) do { const float* cw = P.in[8] + (size_t)l * 4 * 1536 + (which_) * 512 + h * 128 + d; \
            const float w0 = cw[0], w1 = cw[1536], w2 = cw[3072], w3 = cw[4608]; float x0 = 0.f, x1 = 0.f, x2 = 0.f; \
            _Pragma("unroll") for (int t = -3; t < 16; ++t) { const int p = pbase + t; const float xv = p >= 0 ? bf2f(raw[which_][t + 3]) : 0.f; \
                if (t >= 0) { const float y = (w0 * x0 + w1 * x1) + (w2 * x2 + w3 * xv); val_[t] = silu(y); } \
                x0 = x1; x1 = x2; x2 = xv; } } while (0)
#define PB_RED(val_, red_) do { float sq[8]; \
            _Pragma("unroll") for (int i = 0; i < 8; ++i) { const bool hi = (lane & 32) != 0; const float a = val_[i] * val_[i], bq = val_[i + 8] * val_[i + 8]; sq[i] = (hi ? bq : a) + __shfl_xor(hi ? a : bq, 32); } \
            _Pragma("unroll") for (int i = 0; i < 4; ++i) { const bool hi = (lane & 16) != 0; sq[i] = (hi ? sq[i + 4] : sq[i]) + __shfl_xor(hi ? sq[i] : sq[i + 4], 16); } \
            _Pragma("unroll") for (int i = 0; i < 2; ++i) { const bool hi = (lane & 8) != 0; sq[i] = (hi ? sq[i + 2] : sq[i]) + __shfl_xor(hi ? sq[i] : sq[i + 2], 8); } \
            { const bool hi = (lane & 4) != 0; sq[0] = (hi ? sq[1] : sq[0]) + __shfl_xor(hi ? sq[0] : sq[1], 4); } \
            sq[0] += __shfl_xor(sq[0], 1); sq[0] += __shfl_xor(sq[0], 2); \
            if ((lane & 3) == 0) red_[(wave & 1) * 64 + 16 * tq + (lane >> 2)] = sq[0]; } while (0)
          PB_CONV(0, valq); PB_RED(valq, red);
          PB_CONV(1, valk); PB_RED(valk, redk);
          { float bv[16]; PB_CONV(2, bv);
#pragma unroll
            for (int t = 0; t < 16; ++t) bv[t] *= betas[16 * tq + t];
            u32x4 o; o.x = pk2(bv[0], bv[1]); o.y = pk2(bv[2], bv[3]); o.z = pk2(bv[4], bv[5]); o.w = pk2(bv[6], bv[7]); *(LAS u32x4*)(rhsT + d * 72 + 16 * tq) = o;
            o.x = pk2(bv[8], bv[9]); o.y = pk2(bv[10], bv[11]); o.z = pk2(bv[12], bv[13]); o.w = pk2(bv[14], bv[15]); *(LAS u32x4*)(rhsT + d * 72 + 16 * tq + 8) = o; }
          __syncthreads();
#pragma unroll
          for (int t = 0; t < 16; ++t) { const int tk = 16 * tq + t; const float n = rsqrtf(red[tk] + red[64 + tk] + 1e-6f) * 0.08838834764831845f; qs[tk * 136 + d] = (bf16)f2bf(valq[t] * n); }
          { float kd[16], kw[16];
#pragma unroll
            for (int t = 0; t < 16; ++t) { const int tk = 16 * tq + t; const float n = rsqrtf(redk[tk] + redk[64 + tk] + 1e-6f); const float kv = valk[t] * n;
                ks[tk * 136 + d] = (bf16)f2bf(kv); kd[t] = kv * __expf(gl - gcs[tk]); kw[t] = kv * betas[tk] * egc[tk]; }
            u32x4 o; o.x = pk2(kd[0], kd[1]); o.y = pk2(kd[2], kd[3]); o.z = pk2(kd[4], kd[5]); o.w = pk2(kd[6], kd[7]); *(LAS u32x4*)(kdT + d * 72 + 16 * tq) = o;
            o.x = pk2(kd[8], kd[9]); o.y = pk2(kd[10], kd[11]); o.z = pk2(kd[12], kd[13]); o.w = pk2(kd[14], kd[15]); *(LAS u32x4*)(kdT + d * 72 + 16 * tq + 8) = o;
            o.x = pk2(kw[0], kw[1]); o.y = pk2(kw[2], kw[3]); o.z = pk2(kw[4], kw[5]); o.w = pk2(kw[6], kw[7]); *(LAS u32x4*)(rhsT + (128 + d) * 72 + 16 * tq) = o;
            o.x = pk2(kw[8], kw[9]); o.y = pk2(kw[10], kw[11]); o.z = pk2(kw[12], kw[13]); o.w = pk2(kw[14], kw[15]); *(LAS u32x4*)(rhsT + (128 + d) * 72 + 16 * tq + 8) = o; }
#undef PB_CONV
#undef PB_RED
        }
        __syncthreads();
        for (int tt = wave; tt < 32; tt += 8) { const int kind = tt >> 4, tile = tt & 15, mt = tile >> 2, nt = tile & 3;
            if (nt > mt) { if (kind == 1) {
#pragma unroll
                    for (int j = 0; j < 4; ++j) attn[(16 * mt + 4 * q + j) * 72 + 16 * nt + r] = 0; }
                continue; }
            const LAS bf16* X = kind ? qs : ks; f32x4 acc = {0.f, 0.f, 0.f, 0.f};
#pragma unroll
            for (int s = 0; s < 4; ++s) { const bf16x8 a = *(const LAS bf16x8*)(X + (16 * mt + r) * 136 + 32 * s + 8 * q), b = *(const LAS bf16x8*)(ks + (16 * nt + r) * 136 + 32 * s + 8 * q); acc = mfma16(a, b, acc); }
#pragma unroll
            for (int j = 0; j < 4; ++j) { const int cc = 16 * mt + 4 * q + j, ss = 16 * nt + r; const float dec = __expf(gcs[cc] - gcs[ss]);
                if (kind == 0) Am[cc * 68 + ss] = (ss < cc) ? betas[cc] * acc[j] * dec : 0.f;
                else attn[cc * 72 + ss] = (bf16)f2bf((ss <= cc) ? acc[j] * dec : 0.f); } }
        __syncthreads();
        { for (int e = tid; e < 64 * 68; e += 512) TT[e] = 0.f; }
        __syncthreads();
        if (tid < 64) { const int j = tid, b16 = j & ~15, jl = j & 15; float tcol[16];
#pragma unroll
            for (int i = 0; i < 16; ++i) tcol[i] = (i == jl) ? 1.f : 0.f;
#pragma unroll
            for (int i = 1; i < 16; ++i) { float acc = 0.f;
#pragma unroll
                for (int s4 = 0; s4 < (i + 3) / 4; ++s4) { f32x4 av = *(const LAS f32x4*)(Am + (b16 + i) * 68 + b16 + 4 * s4);
#pragma unroll
                    for (int e = 0; e < 4; ++e) if (4 * s4 + e < i) acc += av[e] * tcol[4 * s4 + e]; }
                float tn = (i > jl) ? -acc : tcol[i]; asm volatile("" : "+v"(tn) :: "memory"); tcol[i] = tn; }
#pragma unroll
            for (int i4 = 0; i4 < 4; ++i4) { f32x4 o = {tcol[4 * i4], tcol[4 * i4 + 1], tcol[4 * i4 + 2], tcol[4 * i4 + 3]}; *(LAS f32x4*)(TT + j * 68 + b16 + 4 * i4) = o; } }
        __syncthreads();
        { LAS float* tmpb = (LAS float*)Tb;
#pragma unroll 1
          for (int dd = 1; dd < 4; ++dd) { const int nel = (4 - dd) * 256;
              for (int e = tid; e < nel; e += 512) { const int blk = e >> 8, i = (e >> 4) & 15, j = e & 15, bi = blk + dd, bj = blk; float acc = 0.f;
                  const LAS float* ar = Am + (16 * bi + i) * 68; const LAS float* tr = TT + (16 * bj + j) * 68;
#pragma unroll 4
                  for (int s4 = 4 * bj; s4 < 4 * bi; ++s4) { const f32x4 av = *(const LAS f32x4*)(ar + 4 * s4), tv = *(const LAS f32x4*)(tr + 4 * s4); acc += (av[0] * tv[0] + av[1] * tv[1]) + (av[2] * tv[2] + av[3] * tv[3]); }
                  tmpb[e] = acc; }
              __syncthreads();
              for (int e = tid; e < nel; e += 512) { const int blk = e >> 8, i = (e >> 4) & 15, j = e & 15, bi = blk + dd, bj = blk; float acc = 0.f;
#pragma unroll
                  for (int k = 0; k < 16; ++k) acc += TT[(16 * bi + k) * 68 + 16 * bi + i] * tmpb[(blk << 8) + (k << 4) + j];
                  TT[(16 * bj + j) * 68 + 16 * bi + i] = -acc; }
              __syncthreads(); } }
        { const int cc = tid >> 3, part = tid & 7; float tv[8];
#pragma unroll
          for (int e = 0; e < 8; ++e) tv[e] = TT[(part * 8 + e) * 68 + cc];
          u32x4 o; o.x = pk2(tv[0], tv[1]); o.y = pk2(tv[2], tv[3]); o.z = pk2(tv[4], tv[5]); o.w = pk2(tv[6], tv[7]); *(LAS u32x4*)(Tb + cc * 72 + part * 8) = o; }
        __syncthreads();
        { const int mt = wave & 3, ntb = (wave >> 2) * 8;
          const bf16x8 a0 = *(const LAS bf16x8*)(Tb + (16 * mt + r) * 72 + 8 * q), a1 = *(const LAS bf16x8*)(Tb + (16 * mt + r) * 72 + 32 + 8 * q);
#pragma unroll
          for (int i = 0; i < 8; ++i) { const int nt = ntb + i; f32x4 acc = {0.f, 0.f, 0.f, 0.f};
              const bf16x8 b0 = *(const LAS bf16x8*)(rhsT + (16 * nt + r) * 72 + 8 * q), b1 = *(const LAS bf16x8*)(rhsT + (16 * nt + r) * 72 + 32 + 8 * q);
              acc = mfma16(a0, b0, acc); acc = mfma16(a1, b1, acc);
              u32x2 o; o.x = pk2(acc[0], acc[1]); o.y = pk2(acc[2], acc[3]); *(LAS u32x2*)(uwT + (16 * nt + r) * 72 + 16 * mt + 4 * q) = o; } }
        __syncthreads();
        { const bf16x8 k0 = *(const LAS bf16x8*)(kdT + (16 * wave + r) * 72 + 8 * q), k1 = *(const LAS bf16x8*)(kdT + (16 * wave + r) * 72 + 32 + 8 * q);
#pragma unroll
          for (int nt = 0; nt < 8; ++nt) { f32x4 am = {0.f, 0.f, 0.f, 0.f}, an = {0.f, 0.f, 0.f, 0.f};
              const bf16x8 w0 = *(const LAS bf16x8*)(uwT + (128 + 16 * nt + r) * 72 + 8 * q), w1 = *(const LAS bf16x8*)(uwT + (128 + 16 * nt + r) * 72 + 32 + 8 * q);
              const bf16x8 u0 = *(const LAS bf16x8*)(uwT + (16 * nt + r) * 72 + 8 * q), u1 = *(const LAS bf16x8*)(uwT + (16 * nt + r) * 72 + 32 + 8 * q);
              am = mfma16(w0, k0, am); am = mfma16(w1, k1, am); an = mfma16(k0, u0, an); an = mfma16(k1, u1, an);
              u32x2 o; o.x = pk2(-am[0], -am[1]); o.y = pk2(-am[2], -am[3]); *(u32x2*)(Mp + (size_t)task * 16384 + (16 * wave + r) * 128 + 16 * nt + 4 * q) = o;
              o.x = pk2(an[0], an[1]); o.y = pk2(an[2], an[3]); *(u32x2*)(Nl + (size_t)task * 16384 + ((wave * 8 + nt) * 64 + lane) * 4) = o;
              if (nt & 1) asm volatile("" ::: "memory"); }
          const int mt = wave & 3, ntb = (wave >> 2) * 4, tok = 16 * mt + r; const float e = egc[tok];
          const bf16x8 t0 = *(const LAS bf16x8*)(attn + tok * 72 + 8 * q), t1 = *(const LAS bf16x8*)(attn + tok * 72 + 32 + 8 * q);
#pragma unroll
          for (int i = 0; i < 4; ++i) { const int nt = ntb + i; f32x4 aq = {0.f, 0.f, 0.f, 0.f}, ao = {0.f, 0.f, 0.f, 0.f};
              const bf16x8 w0 = *(const LAS bf16x8*)(uwT + (128 + 16 * nt + r) * 72 + 8 * q), w1 = *(const LAS bf16x8*)(uwT + (128 + 16 * nt + r) * 72 + 32 + 8 * q);
              const bf16x8 u0 = *(const LAS bf16x8*)(uwT + (16 * nt + r) * 72 + 8 * q), u1 = *(const LAS bf16x8*)(uwT + (16 * nt + r) * 72 + 32 + 8 * q);
              aq = mfma16(w0, t0, aq); aq = mfma16(w1, t1, aq); ao = mfma16(u0, t0, ao); ao = mfma16(u1, t1, ao);
              const u32x2 qv = *(const LAS u32x2*)(qs + tok * 136 + 16 * nt + 4 * q);
              u32x2 o; o.x = pk2(bflo(qv.x) * e - aq[0], bfhi(qv.x) * e - aq[1]); o.y = pk2(bflo(qv.y) * e - aq[2], bfhi(qv.y) * e - aq[3]);
              *(u32x2*)(Qp + (size_t)task * 8192 + tok * 128 + 16 * nt + 4 * q) = o;
              o.x = pk2(ao[0], ao[1]); o.y = pk2(ao[2], ao[3]); *(u32x2*)(O0 + (size_t)task * 8192 + tok * 128 + 16 * nt + 4 * q) = o; } }
        asm volatile("s_waitcnt lgkmcnt(0)" ::: "memory"); __builtin_amdgcn_s_barrier(); asm volatile("" ::: "memory");
    }
}
template <int NT> struct StepPre { bf16x8 a[4]; u32x2 n[NT]; float gl; };
template <int NT, int MODE> __device__ __forceinline__ void scan_engine(LAS unsigned char* lds, KP kp) {
    LOAD_PARAMS(kp);
    int tid_ = threadIdx.x; asm volatile("" : "+v"(tid_)); const int tid = tid_, lane = tid & 63, t = tid >> 6, r = lane & 15, q = lane >> 4;
    unsigned char* ws = P.ws;
    const bf16* Mseq = (const bf16*)(ws + (MODE == 0 ? WS_MG : WS_MP)); const bf16* Nseq = (const bf16*)(ws + (MODE == 0 ? WS_NG : WS_NL)); const float* glseq = (const float*)(ws + (MODE == 0 ? WS_GG : WS_GL));
    bf16* Simg = (bf16*)(ws + WS_SIMG);
    constexpr int DEPTH = 4, IMG = 16 * NT * 136;
    const int id = bidx();
    int h, colbase, tb0, nsteps, gh = 0, qd = 0;
    if (MODE == 0) { h = id & 3; colbase = 16 * (id >> 2); tb0 = h; nsteps = 16; }
    else { qd = (id >> 3) & 3; gh = (id & 7) | ((id >> 5) << 3); h = gh & 3; const int g = gh >> 2; tb0 = (16 * g) * 4 + h; nsteps = MODE == 1 ? 16 : 15; colbase = MODE == 1 ? 64 * (qd & 1) : 32 * qd; }
    const bool npart = (MODE != 1) || (qd >= 2);
    const int ntile0 = MODE == 0 ? (id >> 2) : (MODE == 1 ? 4 * (qd & 1) : 2 * qd);
    LAS bf16* img = (LAS bf16*)lds;
    f32x4 X[NT]; float gacc = 1.f;
    float dm[NT][4];
#pragma unroll
    for (int n = 0; n < NT; ++n)
#pragma unroll
        for (int j = 0; j < 4; ++j) dm[n][j] = (MODE == 1 && !npart && (16 * t + 4 * q + j) == (colbase + 16 * n + r)) ? 1.f : 0.f;
    if (MODE == 2 && (gh >> 2) > 0) {
#pragma unroll
        for (int n = 0; n < NT; ++n) { const u32x2 v = *(const u32x2*)(Simg + (size_t)tb0 * 16384 + (colbase + 16 * n + r) * 128 + 16 * t + 4 * q);
            X[n] = (f32x4){bflo(v.x), bfhi(v.x), bflo(v.y), bfhi(v.y)}; *(LAS u32x2*)(img + (16 * n + r) * 136 + 16 * t + 4 * q) = v; }
    } else {
#pragma unroll
        for (int n = 0; n < NT; ++n) { X[n] = (f32x4){0.f, 0.f, 0.f, 0.f}; float d[4];
#pragma unroll
            for (int j = 0; j < 4; ++j) d[j] = dm[n][j];
            u32x2 v; v.x = pk2(d[0], d[1]); v.y = pk2(d[2], d[3]); *(LAS u32x2*)(img + (16 * n + r) * 136 + 16 * t + 4 * q) = v;
            if (MODE == 0) *(u32x2*)(Simg + (size_t)h * 16384 + (colbase + 16 * n + r) * 128 + 16 * t + 4 * q) = v; }
    }
    __syncthreads();
    StepPre<NT> ring[DEPTH];
#define SE_LOAD(c_, PR) do { const size_t tb_ = (size_t)(tb0 + 4 * (c_)); const bf16* mp_ = Mseq + tb_ * 16384 + (16 * t + r) * 128 + 8 * q; \
        PR.a[0] = *(const bf16x8*)(mp_); PR.a[1] = *(const bf16x8*)(mp_ + 32); PR.a[2] = *(const bf16x8*)(mp_ + 64); PR.a[3] = *(const bf16x8*)(mp_ + 96); PR.gl = glseq[tb_]; \
        _Pragma("unroll") for (int n_ = 0; n_ < NT; ++n_) { PR.n[n_] = (u32x2){0u, 0u}; if (npart) PR.n[n_] = *(const u32x2*)(Nseq + tb_ * 16384 + ((t * 8 + ntile0 + n_) * 64 + lane) * 4); } } while (0)
#pragma unroll
    for (int i = 0; i < DEPTH; ++i) if (i < nsteps) SE_LOAD(i, ring[i]);
    for (int c0 = 0; c0 < nsteps; c0 += DEPTH) {
#pragma unroll
        for (int i = 0; i < DEPTH; ++i) { const int c = c0 + i;
            if (c < nsteps) { const LAS bf16* im = img + (c & 1) * IMG + r * 136 + 8 * q; LAS bf16* imn = img + ((c + 1) & 1) * IMG + r * 136 + 16 * t + 4 * q;
                const float gl = ring[i].gl; gacc *= gl;
#pragma unroll
                for (int n = 0; n < NT; ++n) { f32x4 a0 = {0.f, 0.f, 0.f, 0.f}, a1 = {0.f, 0.f, 0.f, 0.f};
                    const bf16x8 b0 = *(const LAS bf16x8*)(im + 16 * n * 136), b1 = *(const LAS bf16x8*)(im + 16 * n * 136 + 32), b2 = *(const LAS bf16x8*)(im + 16 * n * 136 + 64), b3 = *(const LAS bf16x8*)(im + 16 * n * 136 + 96);
                    a0 = mfma16(ring[i].a[0], b0, a0); a1 = mfma16(ring[i].a[1], b1, a1); a0 = mfma16(ring[i].a[2], b2, a0); a1 = mfma16(ring[i].a[3], b3, a1);
                    f32x4 x = X[n]; const u32x2 nn = ring[i].n[n];
                    x[0] = gl * x[0] + bflo(nn.x); x[1] = gl * x[1] + bfhi(nn.x); x[2] = gl * x[2] + bflo(nn.y); x[3] = gl * x[3] + bfhi(nn.y); x = x + (a0 + a1); X[n] = x;
                    float d[4];
#pragma unroll
                    for (int j = 0; j < 4; ++j) d[j] = MODE == 1 ? x[j] + dm[n][j] * gacc : x[j];
                    u32x2 o; o.x = pk2(d[0], d[1]); o.y = pk2(d[2], d[3]); *(LAS u32x2*)(imn + 16 * n * 136) = o;
                    if (MODE == 0) *(u32x2*)(Simg + (size_t)((c + 1) * 64 + h) * 16384 + (colbase + 16 * n + r) * 128 + 16 * t + 4 * q) = o;
                    if (MODE == 2) *(u32x2*)(Simg + (size_t)(tb0 + 4 * (c + 1)) * 16384 + (colbase + 16 * n + r) * 128 + 16 * t + 4 * q) = o; }
                if (c + DEPTH < nsteps) SE_LOAD(c + DEPTH, ring[i]);
                asm volatile("s_waitcnt lgkmcnt(0)" ::: "memory"); __builtin_amdgcn_s_barrier(); asm volatile("" ::: "memory"); } } }
#undef SE_LOAD
    if (MODE == 1) {
        if (!npart) { bf16* MG = (bf16*)(ws + WS_MG);
#pragma unroll
            for (int n = 0; n < NT; ++n)
#pragma unroll
                for (int j = 0; j < 4; ++j) MG[(size_t)gh * 16384 + (16 * t + 4 * q + j) * 128 + colbase + 16 * n + r] = (bf16)f2bf(X[n][j]);
        } else { bf16* NG = (bf16*)(ws + WS_NG);
#pragma unroll
            for (int n = 0; n < NT; ++n) { u32x2 o; o.x = pk2(X[n][0], X[n][1]); o.y = pk2(X[n][2], X[n][3]); *(u32x2*)(NG + (size_t)gh * 16384 + ((t * 8 + ntile0 + n) * 64 + lane) * 4) = o; } }
        if (qd == 0 && tid == 0) ((float*)(ws + WS_GG))[gh] = gacc;
    }
    __syncthreads();
}

__device__ __forceinline__ void conformer_phase(LAS unsigned char* lds, int l, KP kp, int first, int step) {
    LOAD_PARAMS(kp);
    int tid_ = threadIdx.x; asm volatile("" : "+v"(tid_)); const int tid = tid_, lane = tid & 63, wave = tid >> 6, ch = tid;
    unsigned char* ws = P.ws; const bf16* proj = (const bf16*)(ws + WS_PROJ); bf16* Y = (bf16*)(ws + WS_Y);
    LAS float* yl = (LAS float*)lds;
    float dw[31];
#pragma unroll
    for (int j = 0; j < 31; ++j) dw[j] = P.in[4][((size_t)l * 31 + j) * 512 + ch];
    const float bias = P.in[5][l * 512 + ch];
    float lw[8], lb[8];
#pragma unroll
    for (int e = 0; e < 8; ++e) { lw[e] = P.in[6][l * 512 + lane + 64 * e]; lb[e] = P.in[7][l * 512 + lane + 64 * e]; }
    for (int ti = first; ti < NCT; ti += step) {
        const int p0 = ti * CT; float win[31];
#pragma unroll
        for (int k = 0; k < 31; ++k) win[k] = 0.f;
        unsigned short rv[2][31], rg[2][31];
#define CF_LOAD(ib_, B_) do { _Pragma("unroll") for (int k = 0; k < 31; ++k) { const int p = p0 - 30 + (ib_) + k; const bf16* pr = proj + (size_t)pos_row(p < 0 ? 0 : (p >= LTOK ? LTOK - 1 : p)) * NPROJ + ch; rv[B_][k] = pr[0]; rg[B_][k] = pr[512]; } } while (0)
        CF_LOAD(0, 0);
#pragma unroll
        for (int b4 = 0; b4 < 4; ++b4) { const int ib = 31 * b4;
            if (b4 == 0) CF_LOAD(31, 1); else if (b4 == 1) CF_LOAD(62, 0); else if (b4 == 2) CF_LOAD(93, 1);
#pragma unroll
            for (int k = 0; k < 31; ++k) { const int i = ib + k, p = p0 - 30 + i, t = i - 30;
                const float v = bf2f(rv[b4 & 1][k]), g = bf2f(rg[b4 & 1][k]); const float uv = (p >= 0 && p < LTOK) ? v * sigm(g) : 0.f;
                win[k] = uv;
                if (t >= 0 && t < CT) { float y = bias;
#pragma unroll
                    for (int j = 0; j < 31; ++j) y += dw[j] * win[(k + 1 + j) % 31];
                    yl[t * 512 + ch] = y; } } }
#undef CF_LOAD
        __syncthreads();
        { float v[9][8], s1[9], s2[9];
#pragma unroll
          for (int tt = 0; tt < 9; ++tt) { const int t = wave * 9 + tt; const bool ok = (t < CT) && (p0 + t < LTOK); s1[tt] = 0.f; s2[tt] = 0.f;
#pragma unroll
              for (int e = 0; e < 8; ++e) { v[tt][e] = ok ? yl[(ok ? t : 0) * 512 + lane + 64 * e] : 0.f; s1[tt] += v[tt][e]; s2[tt] += v[tt][e] * v[tt][e]; } }
#pragma unroll
          for (int off = 1; off < 64; off <<= 1)
#pragma unroll
              for (int tt = 0; tt < 9; ++tt) { s1[tt] += __shfl_xor(s1[tt], off); s2[tt] += __shfl_xor(s2[tt], off); }
#pragma unroll
          for (int tt = 0; tt < 9; ++tt) { const int t = wave * 9 + tt, p = p0 + t;
              if (t < CT && p < LTOK) { const float mean = s1[tt] * (1.f / 512.f), rstd = rsqrtf(fmaxf(s2[tt] * (1.f / 512.f) - mean * mean, 0.f) + 1e-5f);
                  bf16* yr = Y + (size_t)pos_row(p) * DM;
#pragma unroll
                  for (int e = 0; e < 8; ++e) yr[lane + 64 * e] = (bf16)f2bf(silu((v[tt][e] - mean) * rstd * lw[e] + lb[e])); } } }
        __syncthreads();
    }
}
__device__ __forceinline__ void wconv_phase(LAS unsigned char* lds, int l, KP kp) {
    LOAD_PARAMS(kp);
    int tid_ = threadIdx.x; asm volatile("" : "+v"(tid_)); const int tid = tid_, lane = tid & 63, wave = tid >> 6;
    const int gw = (bidx() - NSCAN) * 8 + wave, ngw = (GRID - NSCAN) * 8; LAS float* scr = (LAS float*)(lds + wave * 8448);
    conv_weight_items(1, l, P, scr, gw, ngw, lane); conv_weight_items(2, l, P, scr, gw, ngw, lane); conv_weight_items(3, l, P, scr, gw, ngw, lane);
    if (l + 1 < DEPTH) conv_weight_items(0, l + 1, P, scr, gw, ngw, lane);
}

struct PostBuf { bf16x8 xa[4]; u32x2 o0[4]; u32x2 zv[4]; };
__device__ __forceinline__ void post_phase(LAS unsigned char* lds, int l, KP kp) {
    LOAD_PARAMS(kp);
    int tid_ = threadIdx.x; asm volatile("" : "+v"(tid_)); const int tid = tid_, lane = tid & 63, wave = tid >> 6, r = lane & 15, q = lane >> 4, mt = wave & 3, nh = wave >> 2;
    unsigned char* ws = P.ws;
    const bf16* Qp = (const bf16*)(ws + WS_QP); const bf16* O0 = (const bf16*)(ws + WS_O0); const bf16* Simg = (const bf16*)(ws + WS_SIMG);
    const bf16* proj = (const bf16*)(ws + WS_PROJ); bf16* Y = (bf16*)(ws + WS_Y); const float* nw = P.in[11] + l * 128;
    LAS float* red = (LAS float*)lds;
    const int tok = 16 * mt + r;
    bf16x8 yb[4][4];
    f32x4 wv[4];
#pragma unroll
    for (int n4 = 0; n4 < 4; ++n4) wv[n4] = *(const f32x4*)(nw + 16 * (4 * nh + n4) + 4 * q);
#define POST_LOAD(task_, B) do { const int c_ = (task_) >> 2, h_ = (task_) & 3; const int row_ = chunk_row(c_, tok); \
        _Pragma("unroll") for (int s = 0; s < 4; ++s) B.xa[s] = *(const bf16x8*)(Qp + (size_t)(task_) * 8192 + tok * 128 + 32 * s + 8 * q); \
        _Pragma("unroll") for (int n4 = 0; n4 < 4; ++n4) { const int nt = 4 * nh + n4; \
            B.o0[n4] = *(const u32x2*)(O0 + (size_t)(task_) * 8192 + tok * 128 + 16 * nt + 4 * q); \
            B.zv[n4] = *(const u32x2*)(proj + (size_t)(row_ < 0 ? 0 : row_) * NPROJ + 2560 + h_ * 128 + 16 * nt + 4 * q); } } while (0)
#define POST_LOAD_YB(task_) do { _Pragma("unroll") for (int n4 = 0; n4 < 4; ++n4) _Pragma("unroll") for (int s = 0; s < 4; ++s) \
        yb[n4][s] = *(const bf16x8*)(Simg + (size_t)(task_) * 16384 + (16 * (4 * nh + n4) + r) * 128 + 32 * s + 8 * q); } while (0)
#define POST_COMP(task_, B, par_, next_) do { const int c_ = (task_) >> 2, h_ = (task_) & 3; f32x4 acc[4]; float sq = 0.f; \
        _Pragma("unroll") for (int n4 = 0; n4 < 4; ++n4) { f32x4 a = {0.f, 0.f, 0.f, 0.f}; \
            if (c_ > 0) { _Pragma("unroll") for (int s = 0; s < 4; ++s) a = mfma16(yb[n4][s], B.xa[s], a); } \
            a[0] += bflo(B.o0[n4].x); a[1] += bfhi(B.o0[n4].x); a[2] += bflo(B.o0[n4].y); a[3] += bfhi(B.o0[n4].y); \
            sq += (a[0] * a[0] + a[1] * a[1]) + (a[2] * a[2] + a[3] * a[3]); acc[n4] = a; } \
        if ((next_) >= 4) POST_LOAD_YB(next_);                                    \
        sq += __shfl_xor(sq, 16); sq += __shfl_xor(sq, 32); \
        if (q == 0) red[(par_) * 128 + nh * 64 + tok] = sq; \
        asm volatile("s_waitcnt lgkmcnt(0)" ::: "memory"); __builtin_amdgcn_s_barrier(); asm volatile("" ::: "memory");        \
        const float rstd = rsqrtf((red[(par_) * 128 + tok] + red[(par_) * 128 + 64 + tok]) * (1.f / 128.f) + 1e-6f); \
        const int row = chunk_row(c_, tok); \
        if (row >= 0) { _Pragma("unroll") for (int n4 = 0; n4 < 4; ++n4) { const int dv = 16 * (4 * nh + n4) + 4 * q; const u32x2 zv = B.zv[n4]; const f32x4 w = wv[n4]; const f32x4 a = acc[n4]; \
                u32x2 o; o.x = pk2(a[0] * rstd * w[0] * silu(bflo(zv.x)), a[1] * rstd * w[1] * silu(bfhi(zv.x))); o.y = pk2(a[2] * rstd * w[2] * silu(bflo(zv.y)), a[3] * rstd * w[3] * silu(bfhi(zv.y))); \
                *(u32x2*)(Y + (size_t)row * DM + 512 + h_ * 128 + dv) = o; } } } while (0)
    PostBuf A, Bq; const int t0 = 4 + bidx();
    POST_LOAD(t0, A); POST_LOAD_YB(t0);
    POST_LOAD(t0 + 256, Bq); POST_COMP(t0, A, 0, t0 + 256);
    POST_LOAD(t0 + 512, A); POST_COMP(t0 + 256, Bq, 1, t0 + 512);
    POST_LOAD(t0 + 768, Bq); POST_COMP(t0 + 512, A, 0, t0 + 768);
    if (bidx() < 4) { POST_LOAD(bidx(), A); POST_COMP(t0 + 768, Bq, 1, -1); POST_COMP(bidx(), A, 0, -1); }
    else POST_COMP(t0 + 768, Bq, 1, -1);
#undef POST_LOAD
#undef POST_LOAD_YB
#undef POST_COMP
    __syncthreads();
}

__device__ __forceinline__ void final_phase(KP kp) {
    LOAD_PARAMS(kp);
    const int lane = threadIdx.x & 63, gw = bidx() * 8 + (threadIdx.x >> 6), ngw = GRID * 8; const float* ssq = (const float*)(P.ws + WS_SSQ);
    f32x4 w[4];
#pragma unroll
    for (int j = 0; j < 4; ++j) w[j] = ((const f32x4*)P.in[16])[lane + 64 * j];
    for (int row0 = gw; row0 < SEQ; row0 += 4 * ngw) {
        float sp[4]; f32x4 v[4][4];
#pragma unroll
        for (int i = 0; i < 4; ++i) { const int row = row0 + i * ngw; sp[i] = lane < 16 ? ssq[(size_t)row * 16 + lane] : 0.f;
#pragma unroll
            for (int j = 0; j < 4; ++j) v[i][j] = ((const f32x4*)(P.out + (size_t)row * DM))[lane + 64 * j]; }
#pragma unroll
        for (int i = 0; i < 4; ++i) { const int row = row0 + i * ngw; const float rstd = rsqrtf(wave_sum(sp[i]) * (1.f / 1024.f) + 1e-6f);
#pragma unroll
            for (int j = 0; j < 4; ++j) ((f32x4*)(P.out + (size_t)row * DM))[lane + 64 * j] = v[i][j] * rstd * w[j]; } }
}

template <int KIND, int K> __device__ __forceinline__ void meta_gemm(LAS unsigned char* lds, const bf16* A, const bf16* Bt, int ntask, KP kp, int first, int step) {
    LOAD_PARAMS(kp);
    int tid_ = threadIdx.x; asm volatile("" : "+v"(tid_)); const int tid = tid_, lane = tid & 63, wave = tid >> 6, r = lane & 15, q = lane >> 4;
    constexpr int NT = KIND == 1 ? 4 : (KIND == 2 ? 2 : 1);
    unsigned char* ws = P.ws; float* ssq = (float*)(ws + WS_SSQ);
    LAS f32x4* part = (LAS f32x4*)lds;
    LAS float* sqx = (LAS float*)(lds + 65536);
    constexpr int kw = K >> 3, NSTEP = kw / 32; const int k0 = wave * kw;
    const bf16* arow = A + (size_t)(SEQ + r) * K + k0 + 8 * q;
    for (int task = first; task < ntask; task += step) {
        f32x4 acc[NT];
        const bf16* brow[NT];
#pragma unroll
        for (int n = 0; n < NT; ++n) { acc[n] = (f32x4){0.f, 0.f, 0.f, 0.f};
            int brw; if (KIND == 0) brw = 16 * task + r; else if (KIND == 1) brw = 64 * task + 16 * n + r; else brw = 256 * (task >> 3) + 128 * n + 16 * (task & 7) + r;
            brow[n] = Bt + (size_t)brw * K + k0 + 8 * q; }
#pragma unroll
        for (int s0 = 0; s0 < NSTEP; s0 += 4) { bf16x8 af[4], bfm[NT][4];
#pragma unroll
            for (int i = 0; i < 4; ++i) if (s0 + i < NSTEP) { af[i] = *(const bf16x8*)(arow + 32 * (s0 + i));
#pragma unroll
                for (int n = 0; n < NT; ++n) bfm[n][i] = *(const bf16x8*)(brow[n] + 32 * (s0 + i)); }
#pragma unroll
            for (int i = 0; i < 4; ++i) if (s0 + i < NSTEP) {
#pragma unroll
                for (int n = 0; n < NT; ++n) acc[n] = mfma16(af[i], bfm[n][i], acc[n]); } }
#pragma unroll
        for (int n = 0; n < NT; ++n) part[(wave * NT + n) * 64 + lane] = acc[n];
        __syncthreads();
        if (wave < (KIND == 1 ? 4 : 1)) { const int n0 = KIND == 1 ? wave : 0;
            f32x4 v[KIND == 2 ? 2 : 1];
#pragma unroll
            for (int n = 0; n < (KIND == 2 ? 2 : 1); ++n) { f32x4 t = part[(0 * NT + n0 + n) * 64 + lane];
#pragma unroll
                for (int w = 1; w < 8; ++w) t = t + part[(w * NT + n0 + n) * 64 + lane];
                v[n] = t; }
            if (KIND == 0 || KIND == 2) { float rs_[4];
#pragma unroll
                for (int j = 0; j < 4; ++j) { const f32x4* p = (const f32x4*)(ssq + (size_t)(SEQ + 4 * q + j) * 16); const f32x4 a = p[0], b = p[1], c = p[2], d = p[3];
                    rs_[j] = rsqrtf((((a[0] + a[1]) + (a[2] + a[3])) + ((b[0] + b[1]) + (b[2] + b[3])) + ((c[0] + c[1]) + (c[2] + c[3])) + ((d[0] + d[1]) + (d[2] + d[3]))) * (1.f / 1024.f) + 1e-6f); }
                if (KIND == 0) { bf16* proj = (bf16*)(ws + WS_PROJ);
#pragma unroll
                    for (int j = 0; j < 4; ++j) proj[(size_t)(SEQ + 4 * q + j) * NPROJ + 16 * task + r] = (bf16)f2bf(v[0][j] * rs_[j]);
                } else { bf16* act = (bf16*)(ws + WS_PROJ);
#pragma unroll
                    for (int j = 0; j < 4; ++j) { const float g = v[0][j] * rs_[j], up = v[KIND == 2 ? 1 : 0][j] * rs_[j]; act[(size_t)(SEQ + 4 * q + j) * DFF + 128 * (task >> 3) + 16 * (task & 7) + r] = (bf16)f2bf(silu(g) * up); } }
            } else { float* hmeta = (float*)(ws + WS_HMETA); bf16* hb = (bf16*)(ws + WS_HB); const int col = 64 * task + 16 * n0 + r;
#pragma unroll
                for (int j = 0; j < 4; ++j) { const int row = 4 * q + j; float hv = hmeta[(size_t)row * DM + col] + v[0][j]; hmeta[(size_t)row * DM + col] = hv; hb[(size_t)(SEQ + row) * DM + col] = (bf16)f2bf(hv);
                    float sq = hv * hv; sq += __shfl_xor(sq, 1); sq += __shfl_xor(sq, 2); sq += __shfl_xor(sq, 4); sq += __shfl_xor(sq, 8);
                    if (r == 0) sqx[n0 * 16 + row] = sq; } }
        }
        __syncthreads();
        if (KIND == 1 && tid < 16) ssq[(size_t)(SEQ + tid) * 16 + task] = (sqx[tid] + sqx[16 + tid]) + (sqx[32 + tid] + sqx[48 + tid]);
        if (KIND == 1) __syncthreads();
    }
}

__device__ __forceinline__ void gates_phase(LAS unsigned char* lds, int l, KP kp) {
    LOAD_PARAMS(kp);
    int tid_ = threadIdx.x; asm volatile("" : "+v"(tid_)); const int tid = tid_, lane = tid & 63, wave = tid >> 6, r = lane & 15, q = lane >> 4;
    unsigned char* ws = P.ws; const bf16* hb = (const bf16*)(ws + WS_HB); const float* ssq = (const float*)(ws + WS_SSQ); const bf16* wb = (const bf16*)(ws + WS_WBAB) + (size_t)l * 16 * DM; float* bg = (float*)(ws + WS_BG);
    LAS f32x4* part = (LAS f32x4*)lds;
    const int k0 = 128 * wave;
    bf16x8 b[4]; bf16x8 a[5][4];
    f32x4 sv[4][4];
    { const int tile = min(bidx() + 256 * (wave < 5 ? wave : 0), 1024);
#pragma unroll
      for (int j = 0; j < 4; ++j) { const f32x4* p = (const f32x4*)(ssq + (size_t)(16 * tile + 4 * q + j) * 16); sv[j][0] = p[0]; sv[j][1] = p[1]; sv[j][2] = p[2]; sv[j][3] = p[3]; } }
#pragma unroll
    for (int s = 0; s < 4; ++s) b[s] = *(const bf16x8*)(wb + (size_t)r * DM + k0 + 32 * s + 8 * q);
#pragma unroll
    for (int j = 0; j < 5; ++j) { const int tile = min(bidx() + 256 * j, 1024);
#pragma unroll
        for (int s = 0; s < 4; ++s) a[j][s] = *(const bf16x8*)(hb + (size_t)(16 * tile + r) * DM + k0 + 32 * s + 8 * q); }
#pragma unroll
    for (int j = 0; j < 5; ++j) { f32x4 acc = {0.f, 0.f, 0.f, 0.f};
#pragma unroll
        for (int s = 0; s < 4; ++s) acc = mfma16(a[j][s], b[s], acc);
        part[(j * 8 + wave) * 64 + lane] = acc; }
    __syncthreads();
    if (wave < 5) { const int tile = bidx() + 256 * wave;
        f32x4 v = part[(wave * 8) * 64 + lane];
#pragma unroll
        for (int w = 1; w < 8; ++w) v = v + part[(wave * 8 + w) * 64 + lane];
#pragma unroll
        for (int j = 0; j < 4; ++j) v[j] += __shfl_xor(v[j], 8);
        if (tile < 1025 && r < 8) {
            const int hh = r & 3; const float nalog = -__expf(P.in[9][l * 4 + hh]), dtb = P.in[10][l * 4 + hh];
#pragma unroll
            for (int j = 0; j < 4; ++j) { const int row = 16 * tile + 4 * q + j; const f32x4 s0 = sv[j][0], s1 = sv[j][1], s2 = sv[j][2], s3 = sv[j][3];
                const float rstd = rsqrtf((((s0[0] + s0[1]) + (s0[2] + s0[3])) + ((s1[0] + s1[1]) + (s1[2] + s1[3])) + ((s2[0] + s2[1]) + (s2[2] + s2[3])) + ((s3[0] + s3[1]) + (s3[2] + s3[3]))) * (1.f / 1024.f) + 1e-6f);
                const float x = v[j] * rstd; float out;
                if (r < 4) out = 1.f / (1.f + __expf(-x)); else { const float av = x + dtb; out = nalog * (av > 20.f ? av : __logf(1.f + __expf(av))); }
                bg[(size_t)row * 8 + r] = out; } } }
    __syncthreads();
}

#define XB_TMO      128
#define XB_XCNT(j)  (256  + 64 * (j))
#define XB_XSUB(j)  (1280 + 64 * (j))
#define XB_XGEN(j)  (2304 + 64 * (j))
#define XB_TOP      3328
#define XB_TOPGEN   3392
#define XCD_BAR_WORDS 3456
#define XB_SPIN_CAP (1u << 18)

__device__ __forceinline__ unsigned xb_ld(unsigned* p)              { return __hip_atomic_load(p, __ATOMIC_RELAXED, __HIP_MEMORY_SCOPE_AGENT); }
__device__ __forceinline__ unsigned xb_add(unsigned* p, unsigned v) { return __hip_atomic_fetch_add(p, v, __ATOMIC_RELAXED, __HIP_MEMORY_SCOPE_AGENT); }
__device__ __forceinline__ unsigned xb_xcc_id() { return (unsigned)__builtin_amdgcn_s_getreg((3 << 11) | 20) & 0xFu; }
#define XB_SPIN(cond, bar) do { unsigned _sp = 0; while (cond) { __builtin_amdgcn_s_sleep(1); \
    if ((++_sp & 255u) == 0u) { if (xb_ld(&(bar)[XB_TMO])) break; if (_sp > XB_SPIN_CAP) { atomicAdd(&(bar)[XB_TMO], 1u); break; } } } } while (0)

struct XcdBarrier {
    unsigned* bar; unsigned x;
    volatile LAS unsigned* st;
};

__device__ __forceinline__ XcdBarrier xcd_barrier_post(unsigned* bar, volatile LAS unsigned* st) {
    XcdBarrier b; b.bar = bar; b.x = xb_xcc_id(); b.st = st;
    if (threadIdx.x == 0) (void)xb_add(&bar[XB_XCNT(b.x)], 1u);
    return b;
}
__device__ __forceinline__ void xcd_barrier_complete(unsigned* bar, unsigned x, unsigned& nloc, unsigned& nx) {
    const unsigned G = gridDim.x * gridDim.y * gridDim.z;
    unsigned sum, cnt, mine, sp = 0u;
    for (;;) {
        sum = 0u; cnt = 0u; mine = 0u;
#pragma unroll
        for (unsigned j = 0; j < 16; ++j) { const unsigned c = xb_ld(&bar[XB_XCNT(j)]); sum += c; cnt += (c > 0u) ? 1u : 0u; mine = (j == x) ? c : mine; }
        if (sum == G) break;
        __builtin_amdgcn_s_sleep(1);
        if ((++sp & 255u) == 0u) { if (xb_ld(&bar[XB_TMO])) break; if (sp > XB_SPIN_CAP) { atomicAdd(&bar[XB_TMO], 1u); break; } }
    }
    nloc = mine > 0u ? mine : 1u; nx = cnt > 0u ? cnt : 1u;
}

__device__ __forceinline__ void xcd_barrier(const XcdBarrier& b) {
    asm volatile("s_waitcnt vmcnt(0)" ::: "memory");
    __syncthreads();
    if (threadIdx.x == 0) {
        unsigned* bar = b.bar;
        __builtin_amdgcn_s_waitcnt(0);
        unsigned nloc = b.st[0], nx = b.st[1];
        if (nloc == 0u) { xcd_barrier_complete(bar, b.x, nloc, nx); b.st[0] = nloc; b.st[1] = nx; }
        const unsigned old = xb_add(&bar[XB_XSUB(b.x)], 1u);
        const unsigned gen = old / nloc;
        if (old + 1u == (gen + 1u) * nloc) {
            __builtin_amdgcn_fence(__ATOMIC_RELEASE, "agent");
            asm volatile("s_waitcnt vmcnt(0)" ::: "memory");
            const unsigned og = xb_add(&bar[XB_TOP], 1u);
            const unsigned tg = og / nx;
            if (og + 1u == (tg + 1u) * nx) xb_add(&bar[XB_TOPGEN], 1u);
            else XB_SPIN(xb_ld(&bar[XB_TOPGEN]) == tg, bar);
            __builtin_amdgcn_fence(__ATOMIC_ACQUIRE, "agent");
            xb_add(&bar[XB_XGEN(b.x)], 1u);
            asm volatile("s_waitcnt vmcnt(0)" ::: "memory");
        } else {
            XB_SPIN(xb_ld(&bar[XB_XGEN(b.x)]) == gen, bar);
            __builtin_amdgcn_fence(__ATOMIC_ACQUIRE, "agent");
            asm volatile("s_waitcnt vmcnt(0)" ::: "memory");
        }
    }
    __syncthreads();
}

__global__ void __launch_bounds__(512, 2) fwd_megakernel(Params Pk) {
    extern __shared__ __attribute__((aligned(16))) unsigned char lds_raw[];
    LAS unsigned char* lds = (LAS unsigned char*)lds_raw;
    cg::grid_group grid = cg::this_grid();
    KP kp = (KP)__builtin_amdgcn_kernarg_segment_ptr();
    LAS float* rs = (LAS float*)(lds + RS_OFF);
    volatile LAS unsigned* bst = (volatile LAS unsigned*)(lds + 147440);
    if (threadIdx.x < 2) bst[threadIdx.x] = 0u;
    __syncthreads();
    { LOAD_PARAMS(kp); (void)xcd_barrier_post((unsigned*)P.ws, bst); }
#define GRID_SYNC() do { LOAD_PARAMS(kp); XcdBarrier xb_; xb_.bar = (unsigned*)P.ws; xb_.x = xb_xcc_id(); xb_.st = (volatile LAS unsigned*)(lds + 147440); xcd_barrier(xb_); } while (0)
    prologue_phase(lds, kp);
    { LOAD_PARAMS(kp); if (P.ws == nullptr) grid.sync(); }
    GRID_SYNC();
    for (int l = 0; l < DEPTH; ++l) {
        { LOAD_PARAMS(kp); unsigned char* ws = P.ws; meta_gemm<0, DM>(lds, (const bf16*)(ws + WS_HB), (const bf16*)(ws + WS_WIN), NPROJ / 16, kp, bidx(), 256);
          pg8::Gemm g{(const bf16*)(ws + WS_HB), (const bf16*)(ws + WS_WIN), SEQ, NPROJ, DM}; pg8::StaticOrder S; S.init(SEQ, NPROJ, GRID, bidx()); fill_rstd(rs, S, (const float*)(ws + WS_SSQ));
          pg8::EpiProj E{(bf16*)(ws + WS_PROJ), NPROJ, rs}; pg8::gemm_phase<pg8::EpiProj, pg8::StaticOrder, true, true>(lds, g, S, E); }
        gates_phase(lds, l, kp);
        GRID_SYNC();
        prep_phase(lds, l, kp);
        { int bid = bidx(); asm volatile("" : "+s"(bid)); if (bid >= 4) { __syncthreads(); conformer_phase(lds, l, kp, bid - 4, 252); } }
        GRID_SYNC();
        scan_engine<4, 1>(lds, kp);
        GRID_SYNC();
        if (bidx() < NSCAN) scan_engine<1, 0>(lds, kp); else wconv_phase(lds, l, kp);
        GRID_SYNC();
        scan_engine<2, 2>(lds, kp);
        GRID_SYNC();
        post_phase(lds, l, kp);
        GRID_SYNC();
        { LOAD_PARAMS(kp); unsigned char* ws = P.ws; meta_gemm<1, DM>(lds, (const bf16*)(ws + WS_Y), (const bf16*)(ws + WS_WOUT), 16, kp, bidx(), 256);
          pg8::Gemm g{(const bf16*)(ws + WS_Y), (const bf16*)(ws + WS_WOUT), SEQ, DM, DM}; pg8::StaticOrder S; S.init(SEQ, DM, GRID, bidx());
          pg8::EpiResid E{P.out, (float*)(ws + WS_HMETA), (bf16*)(ws + WS_HB), (float*)(ws + WS_SSQ)}; pg8::gemm_phase<pg8::EpiResid, pg8::StaticOrder, false, true>(lds, g, S, E);     }
        GRID_SYNC();
        { LOAD_PARAMS(kp); unsigned char* ws = P.ws; if (bidx() >= 128) meta_gemm<2, DM>(lds, (const bf16*)(ws + WS_HB), (const bf16*)(ws + WS_WGU), 176, kp, bidx() - 128, 128);
          pg8::Gemm g{(const bf16*)(ws + WS_HB), (const bf16*)(ws + WS_WGU), SEQ, NGU, DM}; pg8::StaticOrder S; S.init(SEQ, NGU, GRID, bidx()); fill_rstd(rs, S, (const float*)(ws + WS_SSQ));
          pg8::EpiSwiGLU E{(bf16*)(ws + WS_PROJ)  , DFF, rs}; pg8::gemm_phase<pg8::EpiSwiGLU, pg8::StaticOrder, true, true>(lds, g, S, E); }
        GRID_SYNC();
        { LOAD_PARAMS(kp); unsigned char* ws = P.ws; meta_gemm<1, DFF>(lds, (const bf16*)(ws + WS_PROJ), (const bf16*)(ws + WS_WDN), 16, kp, bidx(), 256);
          pg8::Gemm g{(const bf16*)(ws + WS_PROJ), (const bf16*)(ws + WS_WDN), SEQ, DM, DFF}; pg8::StaticOrder S; S.init(SEQ, DM, GRID, bidx());
          pg8::EpiResid E{P.out, (float*)(ws + WS_HMETA), (bf16*)(ws + WS_HB), (float*)(ws + WS_SSQ)}; pg8::gemm_phase<pg8::EpiResid, pg8::StaticOrder, false, true>(lds, g, S, E);     }
        GRID_SYNC();
    }
    final_phase(kp);
}

extern "C" void kernel_launch(void* const* d_in, const int* in_sizes, int n_in, void* d_out, int out_size, void* d_ws, size_t ws_size, hipStream_t stream) {
    static int grid = 0;
    if (grid == 0) {
        if (n_in != 17 || out_size != SEQ * DM || ws_size < WS_END) { fprintf(stderr, "kernel_launch: unexpected shapes (n_in %d, out %d, ws %zu)\n", n_in, out_size, ws_size); grid = -1; return; }
        int dev = 0, cus = 0, per_cu = 0;
        hipGetDevice(&dev); hipDeviceGetAttribute(&cus, hipDeviceAttributeMultiprocessorCount, dev);
        if (hipFuncSetAttribute((const void*)fwd_megakernel, hipFuncAttributeMaxDynamicSharedMemorySize, LDS_BYTES) != hipSuccess) { fprintf(stderr, "kernel_launch: hipFuncSetAttribute failed\n"); grid = -1; return; }
        hipOccupancyMaxActiveBlocksPerMultiprocessor(&per_cu, (const void*)fwd_megakernel, 512, LDS_BYTES);
        (void)hipGetLastError();
        if (per_cu < 1) { fprintf(stderr, "kernel_launch: occupancy query says %d blocks per CU\n", per_cu); per_cu = 1; }
        grid = 256;
        if (cus < 256) { fprintf(stderr, "kernel_launch: needs 256 CUs, device has %d\n", cus); grid = -1; return; }
    }
    if (grid < 0) return;
    if (hipMemsetAsync(d_ws, 0, 16384, stream) != hipSuccess) { fprintf(stderr, "kernel_launch: memset of the barrier words failed\n"); return; }
    Params p{};
    for (int i = 0; i < 17; ++i) p.in[i] = (const float*)d_in[i];
    p.out = (float*)d_out; p.ws = (unsigned char*)d_ws;
    void* args[] = {&p};
    hipError_t e = hipLaunchCooperativeKernel((const void*)fwd_megakernel, dim3(grid), dim3(512), args, LDS_BYTES, stream);
    if (e != hipSuccess) fprintf(stderr, "cooperative launch failed: %s (grid %d)\n", hipGetErrorString(e), grid);
}
```

```cpp
#include <hip/hip_runtime.h>
#include <hip/hip_cooperative_groups.h>
#include <cstdio>
#include <cstdint>
namespace cg = cooperative_groups;
namespace pg8 {
#define PG8_LAS __attribute__((address_space(3)))
typedef unsigned short bf16_t;
typedef short bf16x8 __attribute__((ext_vector_type(8)));
typedef float f32x4 __attribute__((ext_vector_type(4)));
typedef unsigned u32x4 __attribute__((ext_vector_type(4)));
constexpr int BM = 256, BK = 64, HALF = 128, HTB = HALF * BK * 2  , STAGE_BYTES = 8 * HTB, NXCD = 8, WGM = 8;

__host__ __device__ __forceinline__ int lds_byte(int r, int c) { const int st = (r >> 4) * 2 + (c >> 5), rr = r & 15, cc = c & 31, ob = rr * 64 + cc * 2; return st * 1024 + (ob ^ (((ob >> 9) & 1) << 5)); }
__host__ __device__ __forceinline__ void stage_rc(int b, int& R, int& C) { const int st = b / 1024, sb = b % 1024, swz = sb ^ (((sb >> 9) & 1) << 5); R = (st >> 1) * 16 + swz / 64; C = (st & 1) * 32 + (swz % 64) / 2; }
__host__ __device__ __forceinline__ int perm32(int rho) { const int n = rho >> 4, i = rho & 15; return 8 * (i >> 2) + 4 * n + (i & 3); }

struct Unit { int pm, pn, idx; };
struct Gemm { const bf16_t* A; const bf16_t* Bt; int M, N, K; };

struct StaticOrder {
    int nM, nN, nwg, G, c;
    __host__ __device__ void init(int M, int N, int G_, int c_) { nM = M / BM; nN = N / BM; nwg = nM * nN; G = G_; c = c_; }
    __host__ __device__ bool next(int i, Unit& u) const {
        const long L = (long)i * G + c; if (L >= nwg) return false;
        int wgid = (int)L; { const int q = nwg / NXCD, r = nwg % NXCD, xcd = wgid % NXCD, off = wgid / NXCD; wgid = (xcd < r ? xcd * (q + 1) : r * (q + 1) + (xcd - r) * q) + off; }
        const int nig = WGM * nN, gid = wgid / nig, fm = gid * WGM, gsz = (nM - fm) < WGM ? (nM - fm) : WGM;
        u.pm = fm + ((wgid % nig) % gsz); u.pn = (wgid % nig) / gsz; u.idx = i; return true;
    }
    __device__ __forceinline__ void a_ready(const Unit&) const {}
    __device__ __forceinline__ void done(const Unit&) const {}
};

__device__ __forceinline__ unsigned cvt_pk_bf16(float lo, float hi) { unsigned r; asm volatile("v_cvt_pk_bf16_f32 %0, %1, %2" : "=v"(r) : "v"(lo), "v"(hi)); return r; }
typedef float f32x2 __attribute__((ext_vector_type(2)));
typedef unsigned u32x2e __attribute__((ext_vector_type(2)));
struct EpiProj {
    static constexpr bool PERM = true, AFTER_DRAIN = false;
    bf16_t* O; int ldc; const PG8_LAS float* rs;
    __device__ __forceinline__ void operator()(const f32x4 (&acc)[2][2][4][2], const Unit& u, int wr, int wc, int fr, int fq) const {
        const int rl0 = wr * 64 + fr, col0 = u.pn * BM + wc * 32 + 8 * fq;
#pragma unroll
        for (int ai = 0; ai < 2; ++ai)
#pragma unroll
            for (int m = 0; m < 4; ++m) { const int rl = rl0 + ai * HALF + m * 16; const float s = rs[u.idx * 256 + rl];
                bf16_t* rowp = O + (size_t)(u.pm * BM + rl) * ldc + col0;
#pragma unroll
                for (int bj = 0; bj < 2; ++bj) { const f32x4 v0 = acc[ai][bj][m][0] * s, v1 = acc[ai][bj][m][1] * s;
                    u32x4 w; w.x = cvt_pk_bf16(v0[0], v0[1]); w.y = cvt_pk_bf16(v0[2], v0[3]); w.z = cvt_pk_bf16(v1[0], v1[1]); w.w = cvt_pk_bf16(v1[2], v1[3]);
                    *(u32x4*)(rowp + bj * HALF) = w; } }
    }
};
struct EpiSwiGLU {
    static constexpr bool PERM = true, AFTER_DRAIN = false;
    bf16_t* O; int ldc; const PG8_LAS float* rs;
    __device__ __forceinline__ void operator()(const f32x4 (&acc)[2][2][4][2], const Unit& u, int wr, int wc, int fr, int fq) const {
        const int rl0 = wr * 64 + fr, col0 = u.pn * HALF + wc * 32 + 8 * fq;
#pragma unroll
        for (int ai = 0; ai < 2; ++ai)
#pragma unroll
            for (int m = 0; m < 4; ++m) { const int rl = rl0 + ai * HALF + m * 16; const float s = rs[u.idx * 256 + rl];
                float o[8];
#pragma unroll
                for (int n = 0; n < 2; ++n)
#pragma unroll
                    for (int e = 0; e < 4; ++e) { const float g = acc[ai][0][m][n][e] * s, up = acc[ai][1][m][n][e] * s; o[n * 4 + e] = g * __builtin_amdgcn_rcpf(1.f + __expf(-g)) * up; }
                u32x4 w; w.x = cvt_pk_bf16(o[0], o[1]); w.y = cvt_pk_bf16(o[2], o[3]); w.z = cvt_pk_bf16(o[4], o[5]); w.w = cvt_pk_bf16(o[6], o[7]);
                *(u32x4*)(O + (size_t)(u.pm * BM + rl) * ldc + col0) = w; }
    }
};
struct EpiResid {
    static constexpr bool PERM = true, AFTER_DRAIN = false;
    float* hmain; float* hmeta; bf16_t* hb; float* ssq;
    __device__ __forceinline__ void operator()(const f32x4 (&acc)[2][2][4][2], const Unit& u, int wr, int wc, int fr, int fq) const {
        float* hbase = (u.pm < 64) ? hmain : hmeta - (size_t)16384 * 1024;
        const int col0 = u.pn * BM + wc * 32 + 8 * fq;
#pragma unroll
        for (int ai = 0; ai < 2; ++ai)
#pragma unroll
            for (int m = 0; m < 4; ++m) { const int row = u.pm * BM + ai * HALF + wr * 64 + m * 16 + fr; float sq = 0.f;
#pragma unroll
                for (int bj = 0; bj < 2; ++bj) { const size_t off = (size_t)row * 1024 + col0 + bj * HALF;
                    f32x4 h0 = *(const f32x4*)(hbase + off), h1 = *(const f32x4*)(hbase + off + 4);
                    h0 = h0 + acc[ai][bj][m][0]; h1 = h1 + acc[ai][bj][m][1]; *(f32x4*)(hbase + off) = h0; *(f32x4*)(hbase + off + 4) = h1;
                    sq += ((h0[0] * h0[0] + h0[1] * h0[1]) + (h0[2] * h0[2] + h0[3] * h0[3])) + ((h1[0] * h1[0] + h1[1] * h1[1]) + (h1[2] * h1[2] + h1[3] * h1[3]));
                    u32x4 w; w.x = cvt_pk_bf16(h0[0], h0[1]); w.y = cvt_pk_bf16(h0[2], h0[3]); w.z = cvt_pk_bf16(h1[0], h1[1]); w.w = cvt_pk_bf16(h1[2], h1[3]); *(u32x4*)(hb + off) = w; }
                sq += __shfl_xor(sq, 16); sq += __shfl_xor(sq, 32);
                if (fq == 0) ssq[(size_t)row * 16 + u.pn * 4 + wc] = sq; }
    }
};

template <class Epi, class Sched, bool ALIGN_EPI = false, bool SP2 = false>
__device__ __forceinline__ void gemm_phase(PG8_LAS unsigned char* lds, const Gemm g, const Sched& S, const Epi& E) {
    int tid_ = threadIdx.x; asm volatile("" : "+v"(tid_)); const int tid = tid_, wid = __builtin_amdgcn_readfirstlane(tid >> 6), lane = tid & 63, wr = wid >> 2, wc = wid & 3, fr = lane & 15, fq = lane >> 4;
    const int K = g.K, nt = K / BK;
    unsigned voffA[2], voffB[2];
#pragma unroll
    for (int i = 0; i < 2; ++i) { int R, C; stage_rc(tid * 16 + i * 8192, R, C); const int Rb = Epi::PERM ? ((R & ~31) + perm32(R & 31)) : R;
        voffA[i] = (unsigned)(R * K + C) * 2u; voffB[i] = (unsigned)(Rb * K + C) * 2u; }
    const size_t kstep = (size_t)(BK * 2);
    const size_t hstep = (size_t)HALF * K * 2;
    const size_t tstep = 2 * hstep;
    const unsigned ldsw = (unsigned)wid * 1024u;
    const int aoff = lds_byte(wr * 64 + fr, fq * 8), boff = lds_byte(wc * 32 + fr, fq * 8);
#define PG8_SA(b, h) (((b) * 2 + (h)) * HTB)
#define PG8_SB(b, h) ((4 + (b) * 2 + (h)) * HTB)
#define PG8_STAGE(bufoff, gbase, voff) do { _Pragma("unroll") for (int _i = 0; _i < 2; ++_i) \
        __builtin_amdgcn_global_load_lds((const unsigned*)((const char*)(gbase) + (voff)[_i]), (PG8_LAS unsigned*)(lds + (bufoff) + ldsw + _i * 8192), 16, 0, 0); } while (0)
#define PG8_LDA(dst, b, h) do { _Pragma("unroll") for (int m = 0; m < 4; ++m) _Pragma("unroll") for (int k = 0; k < 2; ++k) dst[m][k] = *(const PG8_LAS bf16x8*)(lds + PG8_SA(b, h) + aoff + m * 2048 + k * 1024); } while (0)
#define PG8_LDB(dst, b, h) do { _Pragma("unroll") for (int n = 0; n < 2; ++n) _Pragma("unroll") for (int k = 0; k < 2; ++k) dst[n][k] = *(const PG8_LAS bf16x8*)(lds + PG8_SB(b, h) + boff + n * 2048 + k * 1024); } while (0)
#define PG8_MMA(ai, bj, At, Bt) do { __builtin_amdgcn_s_setprio(1); _Pragma("unroll") for (int m = 0; m < 4; ++m) _Pragma("unroll") for (int n = 0; n < 2; ++n) _Pragma("unroll") for (int k = 0; k < 2; ++k) \
        acc[ai][bj][m][n] = __builtin_amdgcn_mfma_f32_16x16x32_bf16(Bt[n][k], At[m][k], acc[ai][bj][m][n], 0, 0, 0); __builtin_amdgcn_s_setprio(0); } while (0)
#define PG8_WAIT_V(n) asm volatile("s_waitcnt vmcnt(" #n ")" ::: "memory")
#define PG8_WAIT_L(n) asm volatile("s_waitcnt lgkmcnt(" #n ")" ::: "memory")
#define PG8_BAR __builtin_amdgcn_s_barrier()
#define PG8_SCHED __builtin_amdgcn_sched_barrier(0)
    Unit cur, nxt; int ui = 0;
    if (!S.next(0, cur)) return;
    f32x4 acc[2][2][4][2];
#pragma unroll
    for (int a = 0; a < 2; ++a)
#pragma unroll
        for (int b = 0; b < 2; ++b)
#pragma unroll
            for (int m = 0; m < 4; ++m)
#pragma unroll
                for (int n = 0; n < 2; ++n) acc[a][b][m][n] = (f32x4){0.f, 0.f, 0.f, 0.f};
    bf16x8 At[4][2], B0[2][2], B1[2][2];
    const char* cA = (const char*)g.A + (size_t)cur.pm * tstep; const char* cB = (const char*)g.Bt + (size_t)cur.pn * tstep;
    S.a_ready(cur);
    if constexpr (SP2) {
        PG8_STAGE(PG8_SB(0, 0), cB, voffB); PG8_STAGE(PG8_SB(0, 1), cB + hstep, voffB); PG8_STAGE(PG8_SA(0, 0), cA, voffA); PG8_STAGE(PG8_SA(0, 1), cA + hstep, voffA);
        if (wr == 1) PG8_BAR;
        PG8_WAIT_V(2); PG8_BAR;
        PG8_STAGE(PG8_SB(1, 0), cB + kstep, voffB); PG8_STAGE(PG8_SA(1, 0), cA + kstep, voffA); PG8_STAGE(PG8_SB(1, 1), cB + hstep + kstep, voffB);
        PG8_WAIT_V(6); PG8_BAR;
    } else {
        PG8_STAGE(PG8_SB(0, 0), cB, voffB); PG8_STAGE(PG8_SA(0, 0), cA, voffA); PG8_STAGE(PG8_SB(0, 1), cB + hstep, voffB); PG8_STAGE(PG8_SA(0, 1), cA + hstep, voffA);
        if (wr == 1) PG8_BAR;
        PG8_WAIT_V(4); PG8_BAR;
        PG8_STAGE(PG8_SB(1, 0), cB + kstep, voffB); PG8_STAGE(PG8_SA(1, 0), cA + kstep, voffA); PG8_STAGE(PG8_SB(1, 1), cB + hstep + kstep, voffB);
        PG8_WAIT_V(6); PG8_BAR;
    }
    for (;;) {
        const bool has_next = S.next(ui + 1, nxt);
        const char* nA = has_next ? (const char*)g.A + (size_t)nxt.pm * tstep : cA; const char* nB = has_next ? (const char*)g.Bt + (size_t)nxt.pn * tstep : cB;
        for (int t = 0; t < nt; t += 2) {
            const bool last = (t == nt - 2);
            const char* a1 = cA + (size_t)(t + 1) * kstep;
            const char* a2 = last ? nA : cA + (size_t)(t + 2) * kstep; const char* b2 = last ? nB : cB + (size_t)(t + 2) * kstep;
            const char* a3 = a2 + kstep; const char* b3 = b2 + kstep;
            if (last && has_next) S.a_ready(nxt);
            if constexpr (SP2) {
            PG8_LDB(B0, 0, 0); PG8_LDB(B1, 0, 1); PG8_SCHED; PG8_LDA(At, 0, 0); PG8_STAGE(PG8_SA(1, 1), a1 + hstep, voffA);
            PG8_WAIT_V(8); PG8_WAIT_L(0); PG8_BAR; PG8_MMA(0, 0, At, B0); PG8_MMA(0, 1, At, B1); PG8_BAR; PG8_SCHED;
            PG8_LDA(At, 0, 1); PG8_STAGE(PG8_SB(0, 0), b2, voffB); PG8_STAGE(PG8_SB(0, 1), b2 + hstep, voffB); PG8_STAGE(PG8_SA(0, 0), a2, voffA);
            PG8_WAIT_V(8); PG8_WAIT_L(0); PG8_BAR; PG8_MMA(1, 0, At, B0); PG8_MMA(1, 1, At, B1); PG8_BAR; PG8_SCHED;
            PG8_LDB(B0, 1, 0); PG8_LDB(B1, 1, 1); PG8_SCHED; PG8_LDA(At, 1, 0); PG8_STAGE(PG8_SA(0, 1), a2 + hstep, voffA);
            PG8_WAIT_V(8); PG8_WAIT_L(0); PG8_BAR; PG8_MMA(0, 0, At, B0); PG8_MMA(0, 1, At, B1); PG8_BAR; PG8_SCHED;
            PG8_LDA(At, 1, 1); PG8_STAGE(PG8_SB(1, 0), b3, voffB); PG8_STAGE(PG8_SB(1, 1), b3 + hstep, voffB); PG8_STAGE(PG8_SA(1, 0), a3, voffA);
            PG8_WAIT_V(8); PG8_WAIT_L(0); PG8_BAR; PG8_MMA(1, 0, At, B0); PG8_MMA(1, 1, At, B1); PG8_BAR; PG8_SCHED;
            } else {
            PG8_LDB(B0, 0, 0); PG8_SCHED; PG8_LDA(At, 0, 0); PG8_STAGE(PG8_SA(1, 1), a1 + hstep, voffA);
            PG8_WAIT_L(8); PG8_BAR; PG8_WAIT_L(0); PG8_MMA(0, 0, At, B0); PG8_BAR; PG8_SCHED;
            PG8_LDB(B1, 0, 1); PG8_STAGE(PG8_SB(0, 0), b2, voffB);
            PG8_BAR; PG8_WAIT_L(0); PG8_MMA(0, 1, At, B1); PG8_BAR;
            PG8_LDA(At, 0, 1); PG8_STAGE(PG8_SA(0, 0), a2, voffA);
            PG8_BAR; PG8_WAIT_L(0); PG8_MMA(1, 0, At, B0); PG8_BAR; PG8_SCHED;
            PG8_STAGE(PG8_SB(0, 1), b2 + hstep, voffB);
            PG8_WAIT_V(6); PG8_BAR; PG8_MMA(1, 1, At, B1); PG8_BAR;
            PG8_LDB(B0, 1, 0); PG8_SCHED; PG8_LDA(At, 1, 0); PG8_STAGE(PG8_SA(0, 1), a2 + hstep, voffA);
            PG8_WAIT_L(8); PG8_BAR; PG8_WAIT_L(0); PG8_MMA(0, 0, At, B0); PG8_BAR; PG8_SCHED;
            PG8_LDB(B1, 1, 1); PG8_STAGE(PG8_SB(1, 0), b3, voffB);
            PG8_BAR; PG8_WAIT_L(0); PG8_MMA(0, 1, At, B1); PG8_BAR;
            PG8_LDA(At, 1, 1); PG8_STAGE(PG8_SA(1, 0), a3, voffA);
            PG8_BAR; PG8_WAIT_L(0); PG8_MMA(1, 0, At, B0); PG8_BAR; PG8_SCHED;
            PG8_STAGE(PG8_SB(1, 1), b3 + hstep, voffB);
            PG8_WAIT_V(6); PG8_BAR; PG8_MMA(1, 1, At, B1); PG8_BAR;
            }
        }
        if constexpr (ALIGN_EPI) { if (wr == 0) PG8_BAR; }
        if constexpr (!Epi::AFTER_DRAIN) { E(acc, cur, wr, wc, fr, fq); S.done(cur); }
        if (!has_next) break;
#pragma unroll
        for (int a = 0; a < 2; ++a)
#pragma unroll
            for (int b = 0; b < 2; ++b)
#pragma unroll
                for (int m = 0; m < 4; ++m)
#pragma unroll
                    for (int n = 0; n < 2; ++n) acc[a][b][m][n] = (f32x4){0.f, 0.f, 0.f, 0.f};
        cur = nxt; cA = nA; cB = nB; ++ui;
        if constexpr (ALIGN_EPI) { if (wr == 1) PG8_BAR; }
    }
    PG8_WAIT_V(0);
    if constexpr (!ALIGN_EPI) { if (wr == 0) PG8_BAR; }
    PG8_BAR;
    if constexpr (Epi::AFTER_DRAIN) { E.fused(acc, cur, wr, wc, fr, fq, lds, wid, lane); S.done(cur); }
#undef PG8_SA
#undef PG8_SB
#undef PG8_STAGE
#undef PG8_LDA
#undef PG8_LDB
#undef PG8_MMA
#undef PG8_WAIT_V
#undef PG8_WAIT_L
#undef PG8_BAR
#undef PG8_SCHED
}
}
#define LAS __attribute__((address_space(3)))
typedef unsigned short bf16;
typedef short bf16x8 __attribute__((ext_vector_type(8)));
typedef float f32x4 __attribute__((ext_vector_type(4)));
typedef unsigned u32x4 __attribute__((ext_vector_type(4)));
typedef unsigned u32x2 __attribute__((ext_vector_type(2)));

constexpr int DM = 1024, SEQ = 16384, LTOK = 16400, RPAD = 16640, DEPTH = 4;
constexpr int NPROJ = 3072, DIN = 3080, DFF = 2816, NGU = 5632;
constexpr int NTASK = 1028;
constexpr int NSCAN = 32;
constexpr int CT = 66, NCT = 249;
constexpr size_t MiB = 1u << 20;
constexpr size_t WS_WBA = 1 * MiB, WS_GL = 1 * MiB + 256 * 1024, WS_SSQ = 2 * MiB, WS_HMETA = 3 * MiB + 512 * 1024;
constexpr size_t WS_WIN = 5 * MiB, WS_WOUT = 11 * MiB, WS_WGU = 13 * MiB, WS_WDN = 24 * MiB, WS_HB = 30 * MiB, WS_PROJ = 63 * MiB;
constexpr size_t WS_Y = 161 * MiB, WS_MP = 194 * MiB, WS_NL = 227 * MiB, WS_QP = 260 * MiB, WS_O0 = 277 * MiB, WS_SIMG = 294 * MiB, WS_BG = 328 * MiB, WS_MG = 329 * MiB, WS_NG = 332 * MiB, WS_GG = 335 * MiB, WS_WBAB = 336 * MiB, WS_END = 337 * MiB;
constexpr int LDS_BYTES = 147456, RS_OFF = 131072 + 512;

struct Params { const float* in[17]; float* out; unsigned char* ws; };
typedef const __attribute__((address_space(4))) Params* KP;
__device__ __forceinline__ Params load_params(KP kp) {
    Params P{};
#if defined(__HIP_DEVICE_COMPILE__)
    asm volatile("" : "+s"(kp));
#pragma unroll
    for (int i = 0; i < 17; ++i) P.in[i] = kp->in[i];
    P.out = kp->out; P.ws = kp->ws;
#endif
    return P;
}
#define LOAD_PARAMS(kp) const Params P = load_params(kp)

__device__ __forceinline__ int bidx() { int b = blockIdx.x; asm volatile("" : "+s"(b)); return b; }
constexpr int GRID = 256;
__device__ __forceinline__ float bf2f(unsigned v) { return __uint_as_float(v << 16); }
__device__ __forceinline__ float bflo(unsigned v) { return __uint_as_float(v << 16); }
__device__ __forceinline__ float bfhi(unsigned v) { return __uint_as_float(v & 0xffff0000u); }
typedef __bf16 bf16x2_t __attribute__((ext_vector_type(2)));
__device__ __forceinline__ unsigned pk2(float lo, float hi) { bf16x2_t v = {(__bf16)lo, (__bf16)hi}; return __builtin_bit_cast(unsigned, v); }
__device__ __forceinline__ unsigned f2bf(float f) { return pk2(f, f) & 0xffffu; }
__device__ __forceinline__ f32x4 mfma16(bf16x8 a, bf16x8 b, f32x4 c) { return __builtin_amdgcn_mfma_f32_16x16x32_bf16(a, b, c, 0, 0, 0); }
__device__ __forceinline__ float sigm(float x) { return __builtin_amdgcn_rcpf(1.f + __expf(-x)); }
__device__ __forceinline__ float silu(float x) { return x * sigm(x); }
__device__ __forceinline__ float sum8(float v) { v += __int_as_float(__builtin_amdgcn_update_dpp(0, __float_as_int(v), 0xB1, 0xf, 0xf, false)); v += __int_as_float(__builtin_amdgcn_update_dpp(0, __float_as_int(v), 0x4E, 0xf, 0xf, false));
    v += __int_as_float(__builtin_amdgcn_update_dpp(0, __float_as_int(v), 0x141, 0xf, 0xf, false)); return v; }
__device__ __forceinline__ float wave_sum(float v) {
#pragma unroll
    for (int o = 1; o < 64; o <<= 1) v += __shfl_xor(v, o);
    return v;
}
__device__ __forceinline__ float wave_tr_reduce64(float (&v)[64], int lane) {
#pragma unroll
    for (int off = 32; off >= 1; off >>= 1) {
        const bool hi = (lane & off) != 0;
#pragma unroll
        for (int i = 0; i < off; ++i) {
            const float send = hi ? v[i] : v[i + off];
            const float keep = hi ? v[i + off] : v[i];
            v[i] = keep + __shfl_xor(send, off);
        }
    }
    return v[0];
}
__device__ __forceinline__ int pos_row(int p) { return p < 16 ? SEQ + p : p - 16; }
__device__ __forceinline__ int chunk_row(int c, int tok) { return c == 0 ? (tok < 48 ? -1 : SEQ + tok - 48) : 64 * (c - 1) + tok; }

__device__ __forceinline__ void conv_item(const float* __restrict__ W, int Nsrc, int srccol0, const float* __restrict__ scale, bf16* WT, int K, int drow0, int k0, LAS float* scr, int lane) {
    float wv[32];
#pragma unroll
    for (int i = 0; i < 32; ++i) { const int kk = 2 * i + (lane >> 5); wv[i] = W[(size_t)(k0 + kk) * Nsrc + srccol0 + (lane & 31)]; }
    if (scale) {
#pragma unroll
        for (int i = 0; i < 32; ++i) wv[i] *= scale[k0 + 2 * i + (lane >> 5)]; }
#pragma unroll
    for (int i = 0; i < 32; ++i) { const int kk = 2 * i + (lane >> 5); scr[kk * 33 + (lane & 31)] = wv[i]; }
    asm volatile("s_waitcnt lgkmcnt(0)" ::: "memory");
    const int c = lane & 7;
#pragma unroll
    for (int j = 0; j < 4; ++j) { const int n = (lane >> 3) + 8 * j; const LAS float* s = scr + (8 * c) * 33 + n;
        u32x4 o; o.x = pk2(s[0 * 33], s[1 * 33]); o.y = pk2(s[2 * 33], s[3 * 33]); o.z = pk2(s[4 * 33], s[5 * 33]); o.w = pk2(s[6 * 33], s[7 * 33]);
        *(u32x4*)(WT + (size_t)(drow0 + n) * K + k0 + 8 * c) = o; }
    asm volatile("s_waitcnt lgkmcnt(0)" ::: "memory");
}
__device__ __forceinline__ void conv_weight_items(int kind, int l, const Params& P, LAS float* scr, int gw, int ngw, int lane) {
    unsigned char* ws = P.ws;
    if (kind == 0) { const float* W = P.in[3] + (size_t)l * DM * DIN; const float* sc = P.in[2] + l * DM; bf16* WT = (bf16*)(ws + WS_WIN);
        for (int it = gw; it < 16 * 96; it += ngw) { const int kb = it / 96, nb = it % 96; conv_item(W, DIN, 32 * nb, sc, WT, DM, 32 * nb, 64 * kb, scr, lane); } }
    else if (kind == 1) { const float* W = P.in[12] + (size_t)l * DM * DM; bf16* WT = (bf16*)(ws + WS_WOUT);
        for (int it = gw; it < 16 * 32; it += ngw) { const int kb = it / 32, nb = it % 32; conv_item(W, DM, 32 * nb, nullptr, WT, DM, 32 * nb, 64 * kb, scr, lane); } }
    else if (kind == 2) { const float* W = P.in[14] + (size_t)l * DM * NGU; const float* sc = P.in[13] + l * DM; bf16* WT = (bf16*)(ws + WS_WGU);
        for (int it = gw; it < 16 * 176; it += ngw) { const int kb = it / 176, nb = it % 176; const int d0 = 32 * nb, pn = d0 >> 8, j0 = d0 & 255;
            const int src = j0 < 128 ? 128 * pn + j0 : DFF + 128 * pn + (j0 - 128); conv_item(W, NGU, src, sc, WT, DM, d0, 64 * kb, scr, lane); } }
    else { const float* W = P.in[15] + (size_t)l * DFF * DM; bf16* WT = (bf16*)(ws + WS_WDN);
        for (int it = gw; it < 44 * 32; it += ngw) { const int kb = it / 32, nb = it % 32; conv_item(W, DM, 32 * nb, nullptr, WT, DFF, 32 * nb, 64 * kb, scr, lane); } }
}

template <class Sched> __device__ __forceinline__ void fill_rstd(LAS float* rs, const Sched& S, const float* ssq) {
    LAS int* upm = (LAS int*)(rs + 6 * 256);
    if (threadIdx.x < 6) { pg8::Unit u; upm[threadIdx.x] = S.next((int)threadIdx.x, u) ? u.pm : -1; }
    __syncthreads();
    if (threadIdx.x < 256) { f32x4 v[6][4];
#pragma unroll
        for (int i = 0; i < 6; ++i) { const int pm = upm[i]; const f32x4* p = (const f32x4*)(ssq + (size_t)((pm < 0 ? 0 : pm) * 256 + threadIdx.x) * 16); v[i][0] = p[0]; v[i][1] = p[1]; v[i][2] = p[2]; v[i][3] = p[3]; }
#pragma unroll
        for (int i = 0; i < 6; ++i) { const f32x4 a = v[i][0], b = v[i][1], c = v[i][2], d = v[i][3];
            const float s = ((a[0] + a[1]) + (a[2] + a[3])) + ((b[0] + b[1]) + (b[2] + b[3])) + ((c[0] + c[1]) + (c[2] + c[3])) + ((d[0] + d[1]) + (d[2] + d[3]));
            rs[i * 256 + threadIdx.x] = rsqrtf(s * (1.f / 1024.f) + 1e-6f); } }
    __syncthreads();
}

__device__ __forceinline__ void prologue_phase(LAS unsigned char* lds, KP kp) {
    LOAD_PARAMS(kp);
    int tid_ = threadIdx.x; asm volatile("" : "+v"(tid_)); const int tid = tid_, lane = tid & 63, wave = tid >> 6, gw = bidx() * 8 + wave, ngw = GRID * 8;
    unsigned char* ws = P.ws;
    conv_weight_items(0, 0, P, (LAS float*)(lds + wave * 8448), gw, ngw, lane);
    { float* wba = (float*)(ws + WS_WBA);
      for (int i = bidx() * 512 + tid; i < DEPTH * 8 * DM; i += GRID * 512) { const int l = i >> 13, j = (i >> 10) & 7, k = i & 1023;
          wba[i] = P.in[3][((size_t)l * DM + k) * DIN + NPROJ + j] * P.in[2][l * DM + k]; } }
    { bf16* wbab = (bf16*)(ws + WS_WBAB);
      for (int i = bidx() * 512 + tid; i < DEPTH * 16 * DM; i += GRID * 512) { const int l = i >> 14, j = (i >> 10) & 15, k = i & 1023;
          const float wv = P.in[3][((size_t)l * DM + k) * DIN + NPROJ + (j & 7)] * P.in[2][l * DM + k]; const unsigned hi = f2bf(wv);
          wbab[i] = j < 8 ? (bf16)hi : (bf16)f2bf(wv - bf2f(hi)); } }
    { float* hmeta = (float*)(ws + WS_HMETA); bf16* hb = (bf16*)(ws + WS_HB); float* ssq = (float*)(ws + WS_SSQ);
      for (int row = gw; row < RPAD; row += ngw) {
          const float* src = row < SEQ ? P.in[0] + (size_t)row * DM : (row < LTOK ? P.in[1] + (size_t)(row - SEQ) * DM : nullptr);
          float* dst = row < SEQ ? P.out + (size_t)row * DM : hmeta + (size_t)(row - SEQ) * DM; float s = 0.f;
#pragma unroll
          for (int j = 0; j < 4; ++j) { f32x4 v = {0.f, 0.f, 0.f, 0.f}; if (src) v = ((const f32x4*)src)[lane + 64 * j]; ((f32x4*)dst)[lane + 64 * j] = v;
              s += (v[0] * v[0] + v[1] * v[1]) + (v[2] * v[2] + v[3] * v[3]); u32x2 w; w.x = pk2(v[0], v[1]); w.y = pk2(v[2], v[3]); ((u32x2*)(hb + (size_t)row * DM))[lane + 64 * j] = w; }
          s = wave_sum(s); if (lane < 16) ssq[(size_t)row * 16 + lane] = lane == 0 ? s : 0.f; } }
}

__device__ __forceinline__ void prep_phase(LAS unsigned char* lds, int l, KP kp) {
    LOAD_PARAMS(kp);
    int tid_ = threadIdx.x; asm volatile("" : "+v"(tid_)); const int tid = tid_, lane = tid & 63, wave = tid >> 6, r = lane & 15, q = lane >> 4;
    unsigned char* ws = P.ws;
    const bf16* proj = (const bf16*)(ws + WS_PROJ);
    const float* bg = (const float*)(ws + WS_BG); float* glast = (float*)(ws + WS_GL);
    bf16* Mp = (bf16*)(ws + WS_MP); bf16* Nl = (bf16*)(ws + WS_NL); bf16* Qp = (bf16*)(ws + WS_QP); bf16* O0 = (bf16*)(ws + WS_O0);
    LAS bf16* qs = (LAS bf16*)(lds + 0); LAS bf16* ks = (LAS bf16*)(lds + 17408); LAS bf16* rhsT = (LAS bf16*)(lds + 34816);
    LAS bf16* kdT = (LAS bf16*)(lds + 71680); LAS bf16* uwT = (LAS bf16*)(lds + 90112);
    LAS float* Am = (LAS float*)(lds + 90112); LAS float* TT = (LAS float*)(lds + 107520);
    LAS bf16* Tb = (LAS bf16*)(lds + 126976); LAS bf16* attn = (LAS bf16*)(lds + 136192);
    LAS float* gcs = (LAS float*)(lds + 145408); LAS float* betas = gcs + 64; LAS float* egc = gcs + 128; LAS float* red = gcs + 192; LAS float* redk = gcs + 320;
    for (int task = bidx(); task < NTASK; task += GRID) {
        const int c = task >> 2, h = task & 3;
        const int d = tid & 127, tq = tid >> 7, pbase = 64 * c - 48 + 16 * tq;
        unsigned short raw[3][19];
#pragma unroll
        for (int which = 0; which < 3; ++which)
#pragma unroll
            for (int t = 0; t < 19; ++t) { const int p = pbase + t - 3; raw[which][t] = proj[(size_t)pos_row(p < 0 ? 0 : p) * NPROJ + 1024 + which * 512 + h * 128 + d]; }
        if (wave == 0) { const int row = chunk_row(c, lane); float beta = 0.f, g = 0.f; if (row >= 0) { beta = bg[(size_t)row * 8 + h]; g = bg[(size_t)row * 8 + 4 + h]; }
#pragma unroll
            for (int off = 1; off < 64; off <<= 1) { const float t = __shfl_up(g, off); if (lane >= off) g += t; }
            gcs[lane] = g; egc[lane] = expf(g); betas[lane] = beta; if (lane == 63) glast[task] = expf(g); }
        __syncthreads();
        { const float gl = gcs[63]; float valq[16], valk[16];
#define PB_CONV(which_, val_) do { const float* cw = P.in[8] + (size_t)l * 4 * 1536 + (which_) * 512 + h * 128 + d; \
            const float w0 = cw[0], w1 = cw[1536], w2 = cw[3072], w3 = cw[4608]; float x0 = 0.f, x1 = 0.f, x2 = 0.f; \
            _Pragma("unroll") for (int t = -3; t < 16; ++t) { const int p = pbase + t; const float xv = p >= 0 ? bf2f(raw[which_][t + 3]) : 0.f; \
                if (t >= 0) { const float y = (w0 * x0 + w1 * x1) + (w2 * x2 + w3 * xv); val_[t] = silu(y); } \
                x0 = x1; x1 = x2; x2 = xv; } } while (0)
#define PB_RED(val_, red_) do { float sq[8]; \
            _Pragma("unroll") for (int i = 0; i < 8; ++i) { const bool hi = (lane & 32) != 0; const float a = val_[i] * val_[i], bq = val_[i + 8] * val_[i + 8]; sq[i] = (hi ? bq : a) + __shfl_xor(hi ? a : bq, 32); } \
            _Pragma("unroll") for (int i = 0; i < 4; ++i) { const bool hi = (lane & 16) != 0; sq[i] = (hi ? sq[i + 4] : sq[i]) + __shfl_xor(hi ? sq[i] : sq[i + 4], 16); } \
            _Pragma("unroll") for (int i = 0; i < 2; ++i) { const bool hi = (lane & 8) != 0; sq[i] = (hi ? sq[i + 2] : sq[i]) + __shfl_xor(hi ? sq[i] : sq[i + 2], 8); } \
            { const bool hi = (lane & 4) != 0; sq[0] = (hi ? sq[1] : sq[0]) + __shfl_xor(hi ? sq[0] : sq[1], 4); } \
            sq[0] += __shfl_xor(sq[0], 1); sq[0] += __shfl_xor(sq[0], 2); \
            if ((lane & 3) == 0) red_[(wave & 1) * 64 + 16 * tq + (lane >> 2)] = sq[0]; } while (0)
          PB_CONV(0, valq); PB_RED(valq, red);
          PB_CONV(1, valk); PB_RED(valk, redk);
          { float bv[16]; PB_CONV(2, bv);
#pragma unroll
            for (int t = 0; t < 16; ++t) bv[t] *= betas[16 * tq + t];
            u32x4 o; o.x = pk2(bv[0], bv[1]); o.y = pk2(bv[2], bv[3]); o.z = pk2(bv[4], bv[5]); o.w = pk2(bv[6], bv[7]); *(LAS u32x4*)(rhsT + d * 72 + 16 * tq) = o;
            o.x = pk2(bv[8], bv[9]); o.y = pk2(bv[10], bv[11]); o.z = pk2(bv[12], bv[13]); o.w = pk2(bv[14], bv[15]); *(LAS u32x4*)(rhsT + d * 72 + 16 * tq + 8) = o; }
          __syncthreads();
#pragma unroll
          for (int t = 0; t < 16; ++t) { const int tk = 16 * tq + t; const float n = rsqrtf(red[tk] + red[64 + tk] + 1e-6f) * 0.08838834764831845f; qs[tk * 136 + d] = (bf16)f2bf(valq[t] * n); }
          { float kd[16], kw[16];
#pragma unroll
            for (int t = 0; t < 16; ++t) { const int tk = 16 * tq + t; const float n = rsqrtf(redk[tk] + redk[64 + tk] + 1e-6f); const float kv = valk[t] * n;
                ks[tk * 136 + d] = (bf16)f2bf(kv); kd[t] = kv * __expf(gl - gcs[tk]); kw[t] = kv * betas[tk] * egc[tk]; }
            u32x4 o; o.x = pk2(kd[0], kd[1]); o.y = pk2(kd[2], kd[3]); o.z = pk2(kd[4], kd[5]); o.w = pk2(kd[6], kd[7]); *(LAS u32x4*)(kdT + d * 72 + 16 * tq) = o;
            o.x = pk2(kd[8], kd[9]); o.y = pk2(kd[10], kd[11]); o.z = pk2(kd[12], kd[13]); o.w = pk2(kd[14], kd[15]); *(LAS u32x4*)(kdT + d * 72 + 16 * tq + 8) = o;
            o.x = pk2(kw[0], kw[1]); o.y = pk2(kw[2], kw[3]); o.z = pk2(kw[4], kw[5]); o.w = pk2(kw[6], kw[7]); *(LAS u32x4*)(rhsT + (128 + d) * 72 + 16 * tq) = o;
            o.x = pk2(kw[8], kw[9]); o.y = pk2(kw[10], kw[11]); o.z = pk2(kw[12], kw[13]); o.w = pk2(kw[14], kw[15]); *(LAS u32x4*)(rhsT + (128 + d) * 72 + 16 * tq + 8) = o; }
#undef PB_CONV
#undef PB_RED
        }
        __syncthreads();
        for (int tt = wave; tt < 32; tt += 8) { const int kind = tt >> 4, tile = tt & 15, mt = tile >> 2, nt = tile & 3;
            if (nt > mt) { if (kind == 1) {
#pragma unroll
                    for (int j = 0; j < 4; ++j) attn[(16 * mt + 4 * q + j) * 72 + 16 * nt + r] = 0; }
                continue; }
            const LAS bf16* X = kind ? qs : ks; f32x4 acc = {0.f, 0.f, 0.f, 0.f};
#pragma unroll
            for (int s = 0; s < 4; ++s) { const bf16x8 a = *(const LAS bf16x8*)(X + (16 * mt + r) * 136 + 32 * s + 8 * q), b = *(const LAS bf16x8*)(ks + (16 * nt + r) * 136 + 32 * s + 8 * q); acc = mfma16(a, b, acc); }
#pragma unroll
            for (int j = 0; j < 4; ++j) { const int cc = 16 * mt + 4 * q + j, ss = 16 * nt + r; const float dec = __expf(gcs[cc] - gcs[ss]);
                if (kind == 0) Am[cc * 68 + ss] = (ss < cc) ? betas[cc] * acc[j] * dec : 0.f;
                else attn[cc * 72 + ss] = (bf16)f2bf((ss <= cc) ? acc[j] * dec : 0.f); } }
        __syncthreads();
        { for (int e = tid; e < 64 * 68; e += 512) TT[e] = 0.f; }
        __syncthreads();
        if (tid < 64) { const int j = tid, b16 = j & ~15, jl = j & 15; float tcol[16];
#pragma unroll
            for (int i = 0; i < 16; ++i) tcol[i] = (i == jl) ? 1.f : 0.f;
#pragma unroll
            for (int i = 1; i < 16; ++i) { float acc = 0.f;
#pragma unroll
                for (int s4 = 0; s4 < (i + 3) / 4; ++s4) { f32x4 av = *(const LAS f32x4*)(Am + (b16 + i) * 68 + b16 + 4 * s4);
#pragma unroll
                    for (int e = 0; e < 4; ++e) if (4 * s4 + e < i) acc += av[e] * tcol[4 * s4 + e]; }
                float tn = (i > jl) ? -acc : tcol[i]; asm volatile("" : "+v"(tn) :: "memory"); tcol[i] = tn; }
#pragma unroll
            for (int i4 = 0; i4 < 4; ++i4) { f32x4 o = {tcol[4 * i4], tcol[4 * i4 + 1], tcol[4 * i4 + 2], tcol[4 * i4 + 3]}; *(LAS f32x4*)(TT + j * 68 + b16 + 4 * i4) = o; } }
        __syncthreads();
        { LAS float* tmpb = (LAS float*)Tb;
#pragma unroll 1
          for (int dd = 1; dd < 4; ++dd) { const int nel = (4 - dd) * 256;
              for (int e = tid; e < nel; e += 512) { const int blk = e >> 8, i = (e >> 4) & 15, j = e & 15, bi = blk + dd, bj = blk; float acc = 0.f;
                  const LAS float* ar = Am + (16 * bi + i) * 68; const LAS float* tr = TT + (16 * bj + j) * 68;
#pragma unroll 4
                  for (int s4 = 4 * bj; s4 < 4 * bi; ++s4) { const f32x4 av = *(const LAS f32x4*)(ar + 4 * s4), tv = *(const LAS f32x4*)(tr + 4 * s4); acc += (av[0] * tv[0] + av[1] * tv[1]) + (av[2] * tv[2] + av[3] * tv[3]); }
                  tmpb[e] = acc; }
              __syncthreads();
              for (int e = tid; e < nel; e += 512) { const int blk = e >> 8, i = (e >> 4) & 15, j = e & 15, bi = blk + dd, bj = blk; float acc = 0.f;
#pragma unroll
                  for (int k = 0; k < 16; ++k) acc += TT[(16 * bi + k) * 68 + 16 * bi + i] * tmpb[(blk << 8) + (k << 4) + j];
                  TT[(16 * bj + j) * 68 + 16 * bi + i] = -acc; }
              __syncthreads(); } }
        { const int cc = tid >> 3, part = tid & 7; float tv[8];
#pragma unroll
          for (int e = 0; e < 8; ++e) tv[e] = TT[(part * 8 + e) * 68 + cc];
          u32x4 o; o.x = pk2(tv[0], tv[1]); o.y = pk2(tv[2], tv[3]); o.z = pk2(tv[4], tv[5]); o.w = pk2(tv[6], tv[7]); *(LAS u32x4*)(Tb + cc * 72 + part * 8) = o; }
        __syncthreads();
        { const int mt = wave & 3, ntb = (wave >> 2) * 8;
          const bf16x8 a0 = *(const LAS bf16x8*)(Tb + (16 * mt + r) * 72 + 8 * q), a1 = *(const LAS bf16x8*)(Tb + (16 * mt + r) * 72 + 32 + 8 * q);
#pragma unroll
          for (int i = 0; i < 8; ++i) { const int nt = ntb + i; f32x4 acc = {0.f, 0.f, 0.f, 0.f};
              const bf16x8 b0 = *(const LAS bf16x8*)(rhsT + (16 * nt + r) * 72 + 8 * q), b1 = *(const LAS bf16x8*)(rhsT + (16 * nt + r) * 72 + 32 + 8 * q);
              acc = mfma16(a0, b0, acc); acc = mfma16(a1, b1, acc);
              u32x2 o; o.x = pk2(acc[0], acc[1]); o.y = pk2(acc[2], acc[3]); *(LAS u32x2*)(uwT + (16 * nt + r) * 72 + 16 * mt + 4 * q) = o; } }
        __syncthreads();
        { const bf16x8 k0 = *(const LAS bf16x8*)(kdT + (16 * wave + r) * 72 + 8 * q), k1 = *(const LAS bf16x8*)(kdT + (16 * wave + r) * 72 + 32 + 8 * q);
#pragma unroll
          for (int nt = 0; nt < 8; ++nt) { f32x4 am = {0.f, 0.f, 0.f, 0.f}, an = {0.f, 0.f, 0.f, 0.f};
              const bf16x8 w0 = *(const LAS bf16x8*)(uwT + (128 + 16 * nt + r) * 72 + 8 * q), w1 = *(const LAS bf16x8*)(uwT + (128 + 16 * nt + r) * 72 + 32 + 8 * q);
              const bf16x8 u0 = *(const LAS bf16x8*)(uwT + (16 * nt + r) * 72 + 8 * q), u1 = *(const LAS bf16x8*)(uwT + (16 * nt + r) * 72 + 32 + 8 * q);
              am = mfma16(w0, k0, am); am = mfma16(w1, k1, am); an = mfma16(k0, u0, an); an = mfma16(k1, u1, an);
              u32x2 o; o.x = pk2(-am[0], -am[1]); o.y = pk2(-am[2], -am[3]); *(u32x2*)(Mp + (size_t)task * 16384 + (16 * wave + r) * 128 + 16 * nt + 4 * q) = o;
              o.x = pk2(an[0], an[1]); o.y = pk2(an[2], an[3]); *(u32x2*)(Nl + (size_t)task * 16384 + ((wave * 8 + nt) * 64 + lane) * 4) = o;
              if (nt & 1) asm volatile("" ::: "memory"); }
          const int mt = wave & 3, ntb = (wave >> 2) * 4, tok = 16 * mt + r; const float e = egc[tok];
          const bf16x8 t0 = *(const LAS bf16x8*)(attn + tok * 72 + 8 * q), t1 = *(const LAS bf16x8*)(attn + tok * 72 + 32 + 8 * q);
#pragma unroll
          for (int i = 0; i < 4; ++i) { const int nt = ntb + i; f32x4 aq = {0.f, 0.f, 0.f, 0.f}, ao = {0.f, 0.f, 0.f, 0.f};
              const bf16x8 w0 = *(const LAS bf16x8*)(uwT + (128 + 16 * nt + r) * 72 + 8 * q), w1 = *(const LAS bf16x8*)(uwT + (128 + 16 * nt + r) * 72 + 32 + 8 * q);
              const bf16x8 u0 = *(const LAS bf16x8*)(uwT + (16 * nt + r) * 72 + 8 * q), u1 = *(const LAS bf16x8*)(uwT + (16 * nt + r) * 72 + 32 + 8 * q);
              aq = mfma16(w0, t0, aq); aq = mfma16(w1, t1, aq); ao = mfma16(u0, t0, ao); ao = mfma16(u1, t1, ao);
              const u32x2 qv = *(const LAS u32x2*)(qs + tok * 136 + 16 * nt + 4 * q);
              u32x2 o; o.x = pk2(bflo(qv.x) * e - aq[0], bfhi(qv.x) * e - aq[1]); o.y = pk2(bflo(qv.y) * e - aq[2], bfhi(qv.y) * e - aq[3]);
              *(u32x2*)(Qp + (size_t)task * 8192 + tok * 128 + 16 * nt + 4 * q) = o;
              o.x = pk2(ao[0], ao[1]); o.y = pk2(ao[2], ao[3]); *(u32x2*)(O0 + (size_t)task * 8192 + tok * 128 + 16 * nt + 4 * q) = o; } }
        asm volatile("s_waitcnt lgkmcnt(0)" ::: "memory"); __builtin_amdgcn_s_barrier(); asm volatile("" ::: "memory");
    }
}
template <int NT> struct StepPre { bf16x8 a[4]; u32x2 n[NT]; float gl; };
template <int NT, int MODE> __device__ __forceinline__ void scan_engine(LAS unsigned char* lds, KP kp) {
    LOAD_PARAMS(kp);
    int tid_ = threadIdx.x; asm volatile("" : "+v"(tid_)); const int tid = tid_, lane = tid & 63, t = tid >> 6, r = lane & 15, q = lane >> 4;
    unsigned char* ws = P.ws;
    const bf16* Mseq = (const bf16*)(ws + (MODE == 0 ? WS_MG : WS_MP)); const bf16* Nseq = (const bf16*)(ws + (MODE == 0 ? WS_NG : WS_NL)); const float* glseq = (const float*)(ws + (MODE == 0 ? WS_GG : WS_GL));
    bf16* Simg = (bf16*)(ws + WS_SIMG);
    constexpr int DEPTH = 4, IMG = 16 * NT * 136;
    const int id = bidx();
    int h, colbase, tb0, nsteps, gh = 0, qd = 0;
    if (MODE == 0) { h = id & 3; colbase = 16 * (id >> 2); tb0 = h; nsteps = 16; }
    else { qd = (id >> 3) & 3; gh = (id & 7) | ((id >> 5) << 3); h = gh & 3; const int g = gh >> 2; tb0 = (16 * g) * 4 + h; nsteps = MODE == 1 ? 16 : 15; colbase = MODE == 1 ? 64 * (qd & 1) : 32 * qd; }
    const bool npart = (MODE != 1) || (qd >= 2);
    const int ntile0 = MODE == 0 ? (id >> 2) : (MODE == 1 ? 4 * (qd & 1) : 2 * qd);
    LAS bf16* img = (LAS bf16*)lds;
    f32x4 X[NT]; float gacc = 1.f;
    float dm[NT][4];
#pragma unroll
    for (int n = 0; n < NT; ++n)
#pragma unroll
        for (int j = 0; j < 4; ++j) dm[n][j] = (MODE == 1 && !npart && (16 * t + 4 * q + j) == (colbase + 16 * n + r)) ? 1.f : 0.f;
    if (MODE == 2 && (gh >> 2) > 0) {
#pragma unroll
        for (int n = 0; n < NT; ++n) { const u32x2 v = *(const u32x2*)(Simg + (size_t)tb0 * 16384 + (colbase + 16 * n + r) * 128 + 16 * t + 4 * q);
            X[n] = (f32x4){bflo(v.x), bfhi(v.x), bflo(v.y), bfhi(v.y)}; *(LAS u32x2*)(img + (16 * n + r) * 136 + 16 * t + 4 * q) = v; }
    } else {
#pragma unroll
        for (int n = 0; n < NT; ++n) { X[n] = (f32x4){0.f, 0.f, 0.f, 0.f}; float d[4];
#pragma unroll
            for (int j = 0; j < 4; ++j) d[j] = dm[n][j];
            u32x2 v; v.x = pk2(d[0], d[1]); v.y = pk2(d[2], d[3]); *(LAS u32x2*)(img + (16 * n + r) * 136 + 16 * t + 4 * q) = v;
            if (MODE == 0) *(u32x2*)(Simg + (size_t)h * 16384 + (colbase + 16 * n + r) * 128 + 16 * t + 4 * q) = v; }
    }
    __syncthreads();
    StepPre<NT> ring[DEPTH];
#define SE_LOAD(c_, PR) do { const size_t tb_ = (size_t)(tb0 + 4 * (c_)); const bf16* mp_ = Mseq + tb_ * 16384 + (16 * t + r) * 128 + 8 * q; \
        PR.a[0] = *(const bf16x8*)(mp_); PR.a[1] = *(const bf16x8*)(mp_ + 32); PR.a[2] = *(const bf16x8*)(mp_ + 64); PR.a[3] = *(const bf16x8*)(mp_ + 96); PR.gl = glseq[tb_]; \
        _Pragma("unroll") for (int n_ = 0; n_ < NT; ++n_) { PR.n[n_] = (u32x2){0u, 0u}; if (npart) PR.n[n_] = *(const u32x2*)(Nseq + tb_ * 16384 + ((t * 8 + ntile0 + n_) * 64 + lane) * 4); } } while (0)
#pragma unroll
    for (int i = 0; i < DEPTH; ++i) if (i < nsteps) SE_LOAD(i, ring[i]);
    for (int c0 = 0; c0 < nsteps; c0 += DEPTH) {
#pragma unroll
        for (int i = 0; i < DEPTH; ++i) { const int c = c0 + i;
            if (c < nsteps) { const LAS bf16* im = img + (c & 1) * IMG + r * 136 + 8 * q; LAS bf16* imn = img + ((c + 1) & 1) * IMG + r * 136 + 16 * t + 4 * q;
                const float gl = ring[i].gl; gacc *= gl;
#pragma unroll
                for (int n = 0; n < NT; ++n) { f32x4 a0 = {0.f, 0.f, 0.f, 0.f}, a1 = {0.f, 0.f, 0.f, 0.f};
                    const bf16x8 b0 = *(const LAS bf16x8*)(im + 16 * n * 136), b1 = *(const LAS bf16x8*)(im + 16 * n * 136 + 32), b2 = *(const LAS bf16x8*)(im + 16 * n * 136 + 64), b3 = *(const LAS bf16x8*)(im + 16 * n * 136 + 96);
                    a0 = mfma16(ring[i].a[0], b0, a0); a1 = mfma16(ring[i].a[1], b1, a1); a0 = mfma16(ring[i].a[2], b2, a0); a1 = mfma16(ring[i].a[3], b3, a1);
                    f32x4 x = X[n]; const u32x2 nn = ring[i].n[n];
                    x[0] = gl * x[0] + bflo(nn.x); x[1] = gl * x[1] + bfhi(nn.x); x[2] = gl * x[2] + bflo(nn.y); x[3] = gl * x[3] + bfhi(nn.y); x = x + (a0 + a1); X[n] = x;
                    float d[4];
#pragma unroll
                    for (int j = 0; j < 4; ++j) d[j] = MODE == 1 ? x[j] + dm[n][j] * gacc : x[j];
                    u32x2 o; o.x = pk2(d[0], d[1]); o.y = pk2(d[2], d[3]); *(LAS u32x2*)(imn + 16 * n * 136) = o;
                    if (MODE == 0) *(u32x2*)(Simg + (size_t)((c + 1) * 64 + h) * 16384 + (colbase + 16 * n + r) * 128 + 16 * t + 4 * q) = o;
                    if (MODE == 2) *(u32x2*)(Simg + (size_t)(tb0 + 4 * (c + 1)) * 16384 + (colbase + 16 * n + r) * 128 + 16 * t + 4 * q) = o; }
                if (c + DEPTH < nsteps) SE_LOAD(c + DEPTH, ring[i]);
                asm volatile("s_waitcnt lgkmcnt(0)" ::: "memory"); __builtin_amdgcn_s_barrier(); asm volatile("" ::: "memory"); } } }
#undef SE_LOAD
    if (MODE == 1) {
        if (!npart) { bf16* MG = (bf16*)(ws + WS_MG);
#pragma unroll
            for (int n = 0; n < NT; ++n)
#pragma unroll
                for (int j = 0; j < 4; ++j) MG[(size_t)gh * 16384 + (16 * t + 4 * q + j) * 128 + colbase + 16 * n + r] = (bf16)f2bf(X[n][j]);
        } else { bf16* NG = (bf16*)(ws + WS_NG);
#pragma unroll
            for (int n = 0; n < NT; ++n) { u32x2 o; o.x = pk2(X[n][0], X[n][1]); o.y = pk2(X[n][2], X[n][3]); *(u32x2*)(NG + (size_t)gh * 16384 + ((t * 8 + ntile0 + n) * 64 + lane) * 4) = o; } }
        if (qd == 0 && tid == 0) ((float*)(ws + WS_GG))[gh] = gacc;
    }
    __syncthreads();
}

__device__ __forceinline__ void conformer_phase(LAS unsigned char* lds, int l, KP kp, int first, int step) {
    LOAD_PARAMS(kp);
    int tid_ = threadIdx.x; asm volatile("" : "+v"(tid_)); const int tid = tid_, lane = tid & 63, wave = tid >> 6, ch = tid;
    unsigned char* ws = P.ws; const bf16* proj = (const bf16*)(ws + WS_PROJ); bf16* Y = (bf16*)(ws + WS_Y);
    LAS float* yl = (LAS float*)lds;
    float dw[31];
#pragma unroll
    for (int j = 0; j < 31; ++j) dw[j] = P.in[4][((size_t)l * 31 + j) * 512 + ch];
    const float bias = P.in[5][l * 512 + ch];
    float lw[8], lb[8];
#pragma unroll
    for (int e = 0; e < 8; ++e) { lw[e] = P.in[6][l * 512 + lane + 64 * e]; lb[e] = P.in[7][l * 512 + lane + 64 * e]; }
    for (int ti = first; ti < NCT; ti += step) {
        const int p0 = ti * CT; float win[31];
#pragma unroll
        for (int k = 0; k < 31; ++k) win[k] = 0.f;
        unsigned short rv[2][31], rg[2][31];
#define CF_LOAD(ib_, B_) do { _Pragma("unroll") for (int k = 0; k < 31; ++k) { const int p = p0 - 30 + (ib_) + k; const bf16* pr = proj + (size_t)pos_row(p < 0 ? 0 : (p >= LTOK ? LTOK - 1 : p)) * NPROJ + ch; rv[B_][k] = pr[0]; rg[B_][k] = pr[512]; } } while (0)
        CF_LOAD(0, 0);
#pragma unroll
        for (int b4 = 0; b4 < 4; ++b4) { const int ib = 31 * b4;
            if (b4 == 0) CF_LOAD(31, 1); else if (b4 == 1) CF_LOAD(62, 0); else if (b4 == 2) CF_LOAD(93, 1);
#pragma unroll
            for (int k = 0; k < 31; ++k) { const int i = ib + k, p = p0 - 30 + i, t = i - 30;
                const float v = bf2f(rv[b4 & 1][k]), g = bf2f(rg[b4 & 1][k]); const float uv = (p >= 0 && p < LTOK) ? v * sigm(g) : 0.f;
                win[k] = uv;
                if (t >= 0 && t < CT) { float y = bias;
#pragma unroll
                    for (int j = 0; j < 31; ++j) y += dw[j] * win[(k + 1 + j) % 31];
                    yl[t * 512 + ch] = y; } } }
#undef CF_LOAD
        __syncthreads();
        { float v[9][8], s1[9], s2[9];
#pragma unroll
          for (int tt = 0; tt < 9; ++tt) { const int t = wave * 9 + tt; const bool ok = (t < CT) && (p0 + t < LTOK); s1[tt] = 0.f; s2[tt] = 0.f;
#pragma unroll
              for (int e = 0; e < 8; ++e) { v[tt][e] = ok ? yl[(ok ? t : 0) * 512 + lane + 64 * e] : 0.f; s1[tt] += v[tt][e]; s2[tt] += v[tt][e] * v[tt][e]; } }
#pragma unroll
          for (int off = 1; off < 64; off <<= 1)
#pragma unroll
              for (int tt = 0; tt < 9; ++tt) { s1[tt] += __shfl_xor(s1[tt], off); s2[tt] += __shfl_xor(s2[tt], off); }
#pragma unroll
          for (int tt = 0; tt < 9; ++tt) { const int t = wave * 9 + tt, p = p0 + t;
              if (t < CT && p < LTOK) { const float mean = s1[tt] * (1.f / 512.f), rstd = rsqrtf(fmaxf(s2[tt] * (1.f / 512.f) - mean * mean, 0.f) + 1e-5f);
                  bf16* yr = Y + (size_t)pos_row(p) * DM;
#pragma unroll
                  for (int e = 0; e < 8; ++e) yr[lane + 64 * e] = (bf16)f2bf(silu((v[tt][e] - mean) * rstd * lw[e] + lb[e])); } } }
        __syncthreads();
    }
}
__device__ __forceinline__ void wconv_phase(LAS unsigned char* lds, int l, KP kp) {
    LOAD_PARAMS(kp);
    int tid_ = threadIdx.x; asm volatile("" : "+v"(tid_)); const int tid = tid_, lane = tid & 63, wave = tid >> 6;
    const int gw = (bidx() - NSCAN) * 8 + wave, ngw = (GRID - NSCAN) * 8; LAS float* scr = (LAS float*)(lds + wave * 8448);
    conv_weight_items(1, l, P, scr, gw, ngw, lane); conv_weight_items(2, l, P, scr, gw, ngw, lane); conv_weight_items(3, l, P, scr, gw, ngw, lane);
    if (l + 1 < DEPTH) conv_weight_items(0, l + 1, P, scr, gw, ngw, lane);
}

struct PostBuf { bf16x8 xa[4]; u32x2 o0[4]; u32x2 zv[4]; };
__device__ __forceinline__ void post_phase(LAS unsigned char* lds, int l, KP kp) {
    LOAD_PARAMS(kp);
    int tid_ = threadIdx.x; asm volatile("" : "+v"(tid_)); const int tid = tid_, lane = tid & 63, wave = tid >> 6, r = lane & 15, q = lane >> 4, mt = wave & 3, nh = wave >> 2;
    unsigned char* ws = P.ws;
    const bf16* Qp = (const bf16*)(ws + WS_QP); const bf16* O0 = (const bf16*)(ws + WS_O0); const bf16* Simg = (const bf16*)(ws + WS_SIMG);
    const bf16* proj = (const bf16*)(ws + WS_PROJ); bf16* Y = (bf16*)(ws + WS_Y); const float* nw = P.in[11] + l * 128;
    LAS float* red = (LAS float*)lds;
    const int tok = 16 * mt + r;
    bf16x8 yb[4][4];
    f32x4 wv[4];
#pragma unroll
    for (int n4 = 0; n4 < 4; ++n4) wv[n4] = *(const f32x4*)(nw + 16 * (4 * nh + n4) + 4 * q);
#define POST_LOAD(task_, B) do { const int c_ = (task_) >> 2, h_ = (task_) & 3; const int row_ = chunk_row(c_, tok); \
        _Pragma("unroll") for (int s = 0; s < 4; ++s) B.xa[s] = *(const bf16x8*)(Qp + (size_t)(task_) * 8192 + tok * 128 + 32 * s + 8 * q); \
        _Pragma("unroll") for (int n4 = 0; n4 < 4; ++n4) { const int nt = 4 * nh + n4; \
            B.o0[n4] = *(const u32x2*)(O0 + (size_t)(task_) * 8192 + tok * 128 + 16 * nt + 4 * q); \
            B.zv[n4] = *(const u32x2*)(proj + (size_t)(row_ < 0 ? 0 : row_) * NPROJ + 2560 + h_ * 128 + 16 * nt + 4 * q); } } while (0)
#define POST_LOAD_YB(task_) do { _Pragma("unroll") for (int n4 = 0; n4 < 4; ++n4) _Pragma("unroll") for (int s = 0; s < 4; ++s) \
        yb[n4][s] = *(const bf16x8*)(Simg + (size_t)(task_) * 16384 + (16 * (4 * nh + n4) + r) * 128 + 32 * s + 8 * q); } while (0)
#define POST_COMP(task_, B, par_, next_) do { const int c_ = (task_) >> 2, h_ = (task_) & 3; f32x4 acc[4]; float sq = 0.f; \
        _Pragma("unroll") for (int n4 = 0; n4 < 4; ++n4) { f32x4 a = {0.f, 0.f, 0.f, 0.f}; \
            if (c_ > 0) { _Pragma("unroll") for (int s = 0; s < 4; ++s) a = mfma16(yb[n4][s], B.xa[s], a); } \
            a[0] += bflo(B.o0[n4].x); a[1] += bfhi(B.o0[n4].x); a[2] += bflo(B.o0[n4].y); a[3] += bfhi(B.o0[n4].y); \
            sq += (a[0] * a[0] + a[1] * a[1]) + (a[2] * a[2] + a[3] * a[3]); acc[n4] = a; } \
        if ((next_) >= 4) POST_LOAD_YB(next_);                                    \
        sq += __shfl_xor(sq, 16); sq += __shfl_xor(sq, 32); \
        if (q == 0) red[(par_) * 128 + nh * 64 + tok] = sq; \
        asm volatile("s_waitcnt lgkmcnt(0)" ::: "memory"); __builtin_amdgcn_s_barrier(); asm volatile("" ::: "memory");        \
        const float rstd = rsqrtf((red[(par_) * 128 + tok] + red[(par_) * 128 + 64 + tok]) * (1.f / 128.f) + 1e-6f); \
        const int row = chunk_row(c_, tok); \
        if (row >= 0) { _Pragma("unroll") for (int n4 = 0; n4 < 4; ++n4) { const int dv = 16 * (4 * nh + n4) + 4 * q; const u32x2 zv = B.zv[n4]; const f32x4 w = wv[n4]; const f32x4 a = acc[n4]; \
                u32x2 o; o.x = pk2(a[0] * rstd * w[0] * silu(bflo(zv.x)), a[1] * rstd * w[1] * silu(bfhi(zv.x))); o.y = pk2(a[2] * rstd * w[2] * silu(bflo(zv.y)), a[3] * rstd * w[3] * silu(bfhi(zv.y))); \
                *(u32x2*)(Y + (size_t)row * DM + 512 + h_ * 128 + dv) = o; } } } while (0)
    PostBuf A, Bq; const int t0 = 4 + bidx();
    POST_LOAD(t0, A); POST_LOAD_YB(t0);
    POST_LOAD(t0 + 256, Bq); POST_COMP(t0, A, 0, t0 + 256);
    POST_LOAD(t0 + 512, A); POST_COMP(t0 + 256, Bq, 1, t0 + 512);
    POST_LOAD(t0 + 768, Bq); POST_COMP(t0 + 512, A, 0, t0 + 768);
    if (bidx() < 4) { POST_LOAD(bidx(), A); POST_COMP(t0 + 768, Bq, 1, -1); POST_COMP(bidx(), A, 0, -1); }
    else POST_COMP(t0 + 768, Bq, 1, -1);
#undef POST_LOAD
#undef POST_LOAD_YB
#undef POST_COMP
    __syncthreads();
}

__device__ __forceinline__ void final_phase(KP kp) {
    LOAD_PARAMS(kp);
    const int lane = threadIdx.x & 63, gw = bidx() * 8 + (threadIdx.x >> 6), ngw = GRID * 8; const float* ssq = (const float*)(P.ws + WS_SSQ);
    f32x4 w[4];
#pragma unroll
    for (int j = 0; j < 4; ++j) w[j] = ((const f32x4*)P.in[16])[lane + 64 * j];
    for (int row0 = gw; row0 < SEQ; row0 += 4 * ngw) {
        float sp[4]; f32x4 v[4][4];
#pragma unroll
        for (int i = 0; i < 4; ++i) { const int row = row0 + i * ngw; sp[i] = lane < 16 ? ssq[(size_t)row * 16 + lane] : 0.f;
#pragma unroll
            for (int j = 0; j < 4; ++j) v[i][j] = ((const f32x4*)(P.out + (size_t)row * DM))[lane + 64 * j]; }
#pragma unroll
        for (int i = 0; i < 4; ++i) { const int row = row0 + i * ngw; const float rstd = rsqrtf(wave_sum(sp[i]) * (1.f / 1024.f) + 1e-6f);
#pragma unroll
            for (int j = 0; j < 4; ++j) ((f32x4*)(P.out + (size_t)row * DM))[lane + 64 * j] = v[i][j] * rstd * w[j]; } }
}

template <int KIND, int K> __device__ __forceinline__ void meta_gemm(LAS unsigned char* lds, const bf16* A, const bf16* Bt, int ntask, KP kp, int first, int step) {
    LOAD_PARAMS(kp);
    int tid_ = threadIdx.x; asm volatile("" : "+v"(tid_)); const int tid = tid_, lane = tid & 63, wave = tid >> 6, r = lane & 15, q = lane >> 4;
    constexpr int NT = KIND == 1 ? 4 : (KIND == 2 ? 2 : 1);
    unsigned char* ws = P.ws; float* ssq = (float*)(ws + WS_SSQ);
    LAS f32x4* part = (LAS f32x4*)lds;
    LAS float* sqx = (LAS float*)(lds + 65536);
    constexpr int kw = K >> 3, NSTEP = kw / 32; const int k0 = wave * kw;
    const bf16* arow = A + (size_t)(SEQ + r) * K + k0 + 8 * q;
    for (int task = first; task < ntask; task += step) {
        f32x4 acc[NT];
        const bf16* brow[NT];
#pragma unroll
        for (int n = 0; n < NT; ++n) { acc[n] = (f32x4){0.f, 0.f, 0.f, 0.f};
            int brw; if (KIND == 0) brw = 16 * task + r; else if (KIND == 1) brw = 64 * task + 16 * n + r; else brw = 256 * (task >> 3) + 128 * n + 16 * (task & 7) + r;
            brow[n] = Bt + (size_t)brw * K + k0 + 8 * q; }
#pragma unroll
        for (int s0 = 0; s0 < NSTEP; s0 += 4) { bf16x8 af[4], bfm[NT][4];
#pragma unroll
            for (int i = 0; i < 4; ++i) if (s0 + i < NSTEP) { af[i] = *(const bf16x8*)(arow + 32 * (s0 + i));
#pragma unroll
                for (int n = 0; n < NT; ++n) bfm[n][i] = *(const bf16x8*)(brow[n] + 32 * (s0 + i)); }
#pragma unroll
            for (int i = 0; i < 4; ++i) if (s0 + i < NSTEP) {
#pragma unroll
                for (int n = 0; n < NT; ++n) acc[n] = mfma16(af[i], bfm[n][i], acc[n]); } }
#pragma unroll
        for (int n = 0; n < NT; ++n) part[(wave * NT + n) * 64 + lane] = acc[n];
        __syncthreads();
        if (wave < (KIND == 1 ? 4 : 1)) { const int n0 = KIND == 1 ? wave : 0;
            f32x4 v[KIND == 2 ? 2 : 1];
#pragma unroll
            for (int n = 0; n < (KIND == 2 ? 2 : 1); ++n) { f32x4 t = part[(0 * NT + n0 + n) * 64 + lane];
#pragma unroll
                for (int w = 1; w < 8; ++w) t = t + part[(w * NT + n0 + n) * 64 + lane];
                v[n] = t; }
            if (KIND == 0 || KIND == 2) { float rs_[4];
#pragma unroll
                for (int j = 0; j < 4; ++j) { const f32x4* p = (const f32x4*)(ssq + (size_t)(SEQ + 4 * q + j) * 16); const f32x4 a = p[0], b = p[1], c = p[2], d = p[3];
                    rs_[j] = rsqrtf((((a[0] + a[1]) + (a[2] + a[3])) + ((b[0] + b[1]) + (b[2] + b[3])) + ((c[0] + c[1]) + (c[2] + c[3])) + ((d[0] + d[1]) + (d[2] + d[3]))) * (1.f / 1024.f) + 1e-6f); }
                if (KIND == 0) { bf16* proj = (bf16*)(ws + WS_PROJ);
#pragma unroll
                    for (int j = 0; j < 4; ++j) proj[(size_t)(SEQ + 4 * q + j) * NPROJ + 16 * task + r] = (bf16)f2bf(v[0][j] * rs_[j]);
                } else { bf16* act = (bf16*)(ws + WS_PROJ);
#pragma unroll
                    for (int j = 0; j < 4; ++j) { const float g = v[0][j] * rs_[j], up = v[KIND == 2 ? 1 : 0][j] * rs_[j]; act[(size_t)(SEQ + 4 * q + j) * DFF + 128 * (task >> 3) + 16 * (task & 7) + r] = (bf16)f2bf(silu(g) * up); } }
            } else { float* hmeta = (float*)(ws + WS_HMETA); bf16* hb = (bf16*)(ws + WS_HB); const int col = 64 * task + 16 * n0 + r;
#pragma unroll
                for (int j = 0; j < 4; ++j) { const int row = 4 * q + j; float hv = hmeta[(size_t)row * DM + col] + v[0][j]; hmeta[(size_t)row * DM + col] = hv; hb[(size_t)(SEQ + row) * DM + col] = (bf16)f2bf(hv);
                    float sq = hv * hv; sq += __shfl_xor(sq, 1); sq += __shfl_xor(sq, 2); sq += __shfl_xor(sq, 4); sq += __shfl_xor(sq, 8);
                    if (r == 0) sqx[n0 * 16 + row] = sq; } }
        }
        __syncthreads();
        if (KIND == 1 && tid < 16) ssq[(size_t)(SEQ + tid) * 16 + task] = (sqx[tid] + sqx[16 + tid]) + (sqx[32 + tid] + sqx[48 + tid]);
        if (KIND == 1) __syncthreads();
    }
}

__device__ __forceinline__ void gates_phase(LAS unsigned char* lds, int l, KP kp) {
    LOAD_PARAMS(kp);
    int tid_ = threadIdx.x; asm volatile("" : "+v"(tid_)); const int tid = tid_, lane = tid & 63, wave = tid >> 6, r = lane & 15, q = lane >> 4;
    unsigned char* ws = P.ws; const bf16* hb = (const bf16*)(ws + WS_HB); const float* ssq = (const float*)(ws + WS_SSQ); const bf16* wb = (const bf16*)(ws + WS_WBAB) + (size_t)l * 16 * DM; float* bg = (float*)(ws + WS_BG);
    LAS f32x4* part = (LAS f32x4*)lds;
    const int k0 = 128 * wave;
    bf16x8 b[4]; bf16x8 a[5][4];
    f32x4 sv[4][4];
    { const int tile = min(bidx() + 256 * (wave < 5 ? wave : 0), 1024);
#pragma unroll
      for (int j = 0; j < 4; ++j) { const f32x4* p = (const f32x4*)(ssq + (size_t)(16 * tile + 4 * q + j) * 16); sv[j][0] = p[0]; sv[j][1] = p[1]; sv[j][2] = p[2]; sv[j][3] = p[3]; } }
#pragma unroll
    for (int s = 0; s < 4; ++s) b[s] = *(const bf16x8*)(wb + (size_t)r * DM + k0 + 32 * s + 8 * q);
#pragma unroll
    for (int j = 0; j < 5; ++j) { const int tile = min(bidx() + 256 * j, 1024);
#pragma unroll
        for (int s = 0; s < 4; ++s) a[j][s] = *(const bf16x8*)(hb + (size_t)(16 * tile + r) * DM + k0 + 32 * s + 8 * q); }
#pragma unroll
    for (int j = 0; j < 5; ++j) { f32x4 acc = {0.f, 0.f, 0.f, 0.f};
#pragma unroll
        for (int s = 0; s < 4; ++s) acc = mfma16(a[j][s], b[s], acc);
        part[(j * 8 + wave) * 64 + lane] = acc; }
    __syncthreads();
    if (wave < 5) { const int tile = bidx() + 256 * wave;
        f32x4 v = part[(wave * 8) * 64 + lane];
#pragma unroll
        for (int w = 1; w < 8; ++w) v = v + part[(wave * 8 + w) * 64 + lane];
#pragma unroll
        for (int j = 0; j < 4; ++j) v[j] += __shfl_xor(v[j], 8);
        if (tile < 1025 && r < 8) {
            const int hh = r & 3; const float nalog = -__expf(P.in[9][l * 4 + hh]), dtb = P.in[10][l * 4 + hh];
#pragma unroll
            for (int j = 0; j < 4; ++j) { const int row = 16 * tile + 4 * q + j; const f32x4 s0 = sv[j][0], s1 = sv[j][1], s2 = sv[j][2], s3 = sv[j][3];
                const float rstd = rsqrtf((((s0[0] + s0[1]) + (s0[2] + s0[3])) + ((s1[0] + s1[1]) + (s1[2] + s1[3])) + ((s2[0] + s2[1]) + (s2[2] + s2[3])) + ((s3[0] + s3[1]) + (s3[2] + s3[3]))) * (1.f / 1024.f) + 1e-6f);
                const float x = v[j] * rstd; float out;
                if (r < 4) out = 1.f / (1.f + __expf(-x)); else { const float av = x + dtb; out = nalog * (av > 20.f ? av : __logf(1.f + __expf(av))); }
                bg[(size_t)row * 8 + r] = out; } } }
    __syncthreads();
}

#define XB_TMO      128
#define XB_XCNT(j)  (256  + 64 * (j))
#define XB_XSUB(j)  (1280 + 64 * (j))
#define XB_XGEN(j)  (2304 + 64 * (j))
#define XB_TOP      3328
#define XB_TOPGEN   3392
#define XCD_BAR_WORDS 3456
#define XB_SPIN_CAP (1u << 18)

__device__ __forceinline__ unsigned xb_ld(unsigned* p)              { return __hip_atomic_load(p, __ATOMIC_RELAXED, __HIP_MEMORY_SCOPE_AGENT); }
__device__ __forceinline__ unsigned xb_add(unsigned* p, unsigned v) { return __hip_atomic_fetch_add(p, v, __ATOMIC_RELAXED, __HIP_MEMORY_SCOPE_AGENT); }
__device__ __forceinline__ unsigned xb_xcc_id() { return (unsigned)__builtin_amdgcn_s_getreg((3 << 11) | 20) & 0xFu; }
#define XB_SPIN(cond, bar) do { unsigned _sp = 0; while (cond) {        \
    if ((++_sp & 255u) == 0u) { if (xb_ld(&(bar)[XB_TMO])) break; if (_sp > XB_SPIN_CAP) { atomicAdd(&(bar)[XB_TMO], 1u); break; } } } } while (0)

struct XcdBarrier {
    unsigned* bar; unsigned x;
    volatile LAS unsigned* st;
};

__device__ __forceinline__ XcdBarrier xcd_barrier_post(unsigned* bar, volatile LAS unsigned* st) {
    XcdBarrier b; b.bar = bar; b.x = xb_xcc_id(); b.st = st;
    if (threadIdx.x == 0) (void)xb_add(&bar[XB_XCNT(b.x)], 1u);
    return b;
}
__device__ __forceinline__ void xcd_barrier_complete(unsigned* bar, unsigned x, unsigned& nloc, unsigned& nx) {
    const unsigned G = gridDim.x * gridDim.y * gridDim.z;
    unsigned sum, cnt, mine, sp = 0u;
    for (;;) {
        sum = 0u; cnt = 0u; mine = 0u;
#pragma unroll
        for (unsigned j = 0; j < 16; ++j) { const unsigned c = xb_ld(&bar[XB_XCNT(j)]); sum += c; cnt += (c > 0u) ? 1u : 0u; mine = (j == x) ? c : mine; }
        if (sum == G) break;
        __builtin_amdgcn_s_sleep(1);
        if ((++sp & 255u) == 0u) { if (xb_ld(&bar[XB_TMO])) break; if (sp > XB_SPIN_CAP) { atomicAdd(&bar[XB_TMO], 1u); break; } }
    }
    nloc = mine > 0u ? mine : 1u; nx = cnt > 0u ? cnt : 1u;
}

__device__ __forceinline__ void xcd_barrier(const XcdBarrier& b) {
    asm volatile("s_waitcnt vmcnt(0)" ::: "memory");
    __syncthreads();
    if (threadIdx.x == 0) {
        unsigned* bar = b.bar;
        __builtin_amdgcn_s_waitcnt(0);
        unsigned nloc = b.st[0], nx = b.st[1];
        if (nloc == 0u) { xcd_barrier_complete(bar, b.x, nloc, nx); b.st[0] = nloc; b.st[1] = nx; }
        const unsigned old = xb_add(&bar[XB_XSUB(b.x)], 1u);
        const unsigned gen = old / nloc;
        if (old + 1u == (gen + 1u) * nloc) {
            __builtin_amdgcn_fence(__ATOMIC_RELEASE, "agent");
            asm volatile("s_waitcnt vmcnt(0)" ::: "memory");
            const unsigned og = xb_add(&bar[XB_TOP], 1u);
            const unsigned tg = og / nx;
            if (og + 1u == (tg + 1u) * nx) xb_add(&bar[XB_TOPGEN], 1u);
            else XB_SPIN(xb_ld(&bar[XB_TOPGEN]) == tg, bar);
            __builtin_amdgcn_fence(__ATOMIC_ACQUIRE, "agent");
            xb_add(&bar[XB_XGEN(b.x)], 1u);
            asm volatile("s_waitcnt vmcnt(0)" ::: "memory");
        } else {
            XB_SPIN(xb_ld(&bar[XB_XGEN(b.x)]) == gen, bar);
            __builtin_amdgcn_fence(__ATOMIC_ACQUIRE, "agent");
            asm volatile("s_waitcnt vmcnt(0)" ::: "memory");
        }
    }
    __syncthreads();
}

__global__ void __launch_bounds__(512, 2) fwd_megakernel(Params Pk) {
    extern __shared__ __attribute__((aligned(16))) unsigned char lds_raw[];
    LAS unsigned char* lds = (LAS unsigned char*)lds_raw;
    cg::grid_group grid = cg::this_grid();
    KP kp = (KP)__builtin_amdgcn_kernarg_segment_ptr();
    LAS float* rs = (LAS float*)(lds + RS_OFF);
    volatile LAS unsigned* bst = (volatile LAS unsigned*)(lds + 147440);
    if (threadIdx.x < 2) bst[threadIdx.x] = 0u;
    __syncthreads();
    { LOAD_PARAMS(kp); (void)xcd_barrier_post((unsigned*)P.ws, bst); }
#define GRID_SYNC() do { LOAD_PARAMS(kp); XcdBarrier xb_; xb_.bar = (unsigned*)P.ws; xb_.x = xb_xcc_id(); xb_.st = (volatile LAS unsigned*)(lds + 147440); xcd_barrier(xb_); } while (0)
    prologue_phase(lds, kp);
    { LOAD_PARAMS(kp); if (P.ws == nullptr) grid.sync(); }
    GRID_SYNC();
    for (int l = 0; l < DEPTH; ++l) {
        { LOAD_PARAMS(kp); unsigned char* ws = P.ws; meta_gemm<0, DM>(lds, (const bf16*)(ws + WS_HB), (const bf16*)(ws + WS_WIN), NPROJ / 16, kp, bidx(), 256);
          pg8::Gemm g{(const bf16*)(ws + WS_HB), (const bf16*)(ws + WS_WIN), SEQ, NPROJ, DM}; pg8::StaticOrder S; S.init(SEQ, NPROJ, GRID, bidx()); fill_rstd(rs, S, (const float*)(ws + WS_SSQ));
          pg8::EpiProj E{(bf16*)(ws + WS_PROJ), NPROJ, rs}; pg8::gemm_phase<pg8::EpiProj, pg8::StaticOrder, true, true>(lds, g, S, E); }
        gates_phase(lds, l, kp);
        GRID_SYNC();
        prep_phase(lds, l, kp);
        { int bid = bidx(); asm volatile("" : "+s"(bid)); if (bid >= 4) { __syncthreads(); conformer_phase(lds, l, kp, bid - 4, 252); } }
        GRID_SYNC();
        scan_engine<4, 1>(lds, kp);
        GRID_SYNC();
        if (bidx() < NSCAN) scan_engine<1, 0>(lds, kp); else wconv_phase(lds, l, kp);
        GRID_SYNC();
        scan_engine<2, 2>(lds, kp);
        GRID_SYNC();
        post_phase(lds, l, kp);
        GRID_SYNC();
        { LOAD_PARAMS(kp); unsigned char* ws = P.ws; meta_gemm<1, DM>(lds, (const bf16*)(ws + WS_Y), (const bf16*)(ws + WS_WOUT), 16, kp, bidx(), 256);
          pg8::Gemm g{(const bf16*)(ws + WS_Y), (const bf16*)(ws + WS_WOUT), SEQ, DM, DM}; pg8::StaticOrder S; S.init(SEQ, DM, GRID, bidx());
          pg8::EpiResid E{P.out, (float*)(ws + WS_HMETA), (bf16*)(ws + WS_HB), (float*)(ws + WS_SSQ)}; pg8::gemm_phase<pg8::EpiResid, pg8::StaticOrder, true, true>(lds, g, S, E); }
        GRID_SYNC();
        { LOAD_PARAMS(kp); unsigned char* ws = P.ws; if (bidx() >= 128) meta_gemm<2, DM>(lds, (const bf16*)(ws + WS_HB), (const bf16*)(ws + WS_WGU), 176, kp, bidx() - 128, 128);
          pg8::Gemm g{(const bf16*)(ws + WS_HB), (const bf16*)(ws + WS_WGU), SEQ, NGU, DM}; pg8::StaticOrder S; S.init(SEQ, NGU, GRID, bidx()); fill_rstd(rs, S, (const float*)(ws + WS_SSQ));
          pg8::EpiSwiGLU E{(bf16*)(ws + WS_PROJ)  , DFF, rs}; pg8::gemm_phase<pg8::EpiSwiGLU, pg8::StaticOrder, true, true>(lds, g, S, E); }
        GRID_SYNC();
        { LOAD_PARAMS(kp); unsigned char* ws = P.ws; meta_gemm<1, DFF>(lds, (const bf16*)(ws + WS_PROJ), (const bf16*)(ws + WS_WDN), 16, kp, bidx(), 256);
          pg8::Gemm g{(const bf16*)(ws + WS_PROJ), (const bf16*)(ws + WS_WDN), SEQ, DM, DFF}; pg8::StaticOrder S; S.init(SEQ, DM, GRID, bidx());
          pg8::EpiResid E{P.out, (float*)(ws + WS_HMETA), (bf16*)(ws + WS_HB), (float*)(ws + WS_SSQ)}; pg8::gemm_phase<pg8::EpiResid, pg8::StaticOrder, true, true>(lds, g, S, E); }
        GRID_SYNC();
    }
    final_phase(kp);
}

extern "C" void kernel_launch(void* const* d_in, const int* in_sizes, int n_in, void* d_out, int out_size, void* d_ws, size_t ws_size, hipStream_t stream) {
    static int grid = 0;
    if (grid == 0) {
        if (n_in != 17 || out_size != SEQ * DM || ws_size < WS_END) { fprintf(stderr, "kernel_launch: unexpected shapes (n_in %d, out %d, ws %zu)\n", n_in, out_size, ws_size); grid = -1; return; }
        int dev = 0, cus = 0, per_cu = 0;
        hipGetDevice(&dev); hipDeviceGetAttribute(&cus, hipDeviceAttributeMultiprocessorCount, dev);
        if (hipFuncSetAttribute((const void*)fwd_megakernel, hipFuncAttributeMaxDynamicSharedMemorySize, LDS_BYTES) != hipSuccess) { fprintf(stderr, "kernel_launch: hipFuncSetAttribute failed\n"); grid = -1; return; }
        hipOccupancyMaxActiveBlocksPerMultiprocessor(&per_cu, (const void*)fwd_megakernel, 512, LDS_BYTES);
        (void)hipGetLastError();
        if (per_cu < 1) { fprintf(stderr, "kernel_launch: occupancy query says %d blocks per CU\n", per_cu); per_cu = 1; }
        grid = 256;
        if (cus < 256) { fprintf(stderr, "kernel_launch: needs 256 CUs, device has %d\n", cus); grid = -1; return; }
    }
    if (grid < 0) return;
    if (hipMemsetAsync(d_ws, 0, 16384, stream) != hipSuccess) { fprintf(stderr, "kernel_launch: memset of the barrier words failed\n"); return; }
    Params p{};
    for (int i = 0; i < 17; ++i) p.in[i] = (const float*)d_in[i];
    p.out = (float*)d_out; p.ws = (unsigned char*)d_ws;
    void* args[] = {&p};
    hipError_t e = hipLaunchCooperativeKernel((const void*)fwd_megakernel, dim3(grid), dim3(512), args, LDS_BYTES, stream);
    if (e != hipSuccess) fprintf(stderr, "cooperative launch failed: %s (grid %d)\n", hipGetErrorString(e), grid);
}
```

```cpp
#include <hip/hip_runtime.h>
#include <hip/hip_cooperative_groups.h>
#include <cstdio>
#include <cstdint>
namespace cg = cooperative_groups;
namespace pg8 {
#define PG8_LAS __attribute__((address_space(3)))
typedef unsigned short bf16_t;
typedef short bf16x8 __attribute__((ext_vector_type(8)));
typedef float f32x4 __attribute__((ext_vector_type(4)));
typedef unsigned u32x4 __attribute__((ext_vector_type(4)));
constexpr int BM = 256, BK = 64, HALF = 128, HTB = HALF * BK * 2  , STAGE_BYTES = 8 * HTB, NXCD = 8, WGM = 8;

__host__ __device__ __forceinline__ int lds_byte(int r, int c) { const int st = (r >> 4) * 2 + (c >> 5), rr = r & 15, cc = c & 31, ob = rr * 64 + cc * 2; return st * 1024 + (ob ^ (((ob >> 9) & 1) << 5)); }
__host__ __device__ __forceinline__ void stage_rc(int b, int& R, int& C) { const int st = b / 1024, sb = b % 1024, swz = sb ^ (((sb >> 9) & 1) << 5); R = (st >> 1) * 16 + swz / 64; C = (st & 1) * 32 + (swz % 64) / 2; }
__host__ __device__ __forceinline__ int perm32(int rho) { const int n = rho >> 4, i = rho & 15; return 8 * (i >> 2) + 4 * n + (i & 3); }

struct Unit { int pm, pn, idx; };
struct Gemm { const bf16_t* A; const bf16_t* Bt; int M, N, K; };

struct StaticOrder {
    int nM, nN, nwg, G, c;
    __host__ __device__ void init(int M, int N, int G_, int c_) { nM = M / BM; nN = N / BM; nwg = nM * nN; G = G_; c = c_; }
    __host__ __device__ bool next(int i, Unit& u) const {
        const long L = (long)i * G + c; if (L >= nwg) return false;
        int wgid = (int)L; { const int q = nwg / NXCD, r = nwg % NXCD, xcd = wgid % NXCD, off = wgid / NXCD; wgid = (xcd < r ? xcd * (q + 1) : r * (q + 1) + (xcd - r) * q) + off; }
        const int nig = WGM * nN, gid = wgid / nig, fm = gid * WGM, gsz = (nM - fm) < WGM ? (nM - fm) : WGM;
        u.pm = fm + ((wgid % nig) % gsz); u.pn = (wgid % nig) / gsz; u.idx = i; return true;
    }
    __device__ __forceinline__ void a_ready(const Unit&) const {}
    __device__ __forceinline__ void done(const Unit&) const {}
};

__device__ __forceinline__ unsigned cvt_pk_bf16(float lo, float hi) { unsigned r; asm volatile("v_cvt_pk_bf16_f32 %0, %1, %2" : "=v"(r) : "v"(lo), "v"(hi)); return r; }
typedef float f32x2 __attribute__((ext_vector_type(2)));
typedef unsigned u32x2e __attribute__((ext_vector_type(2)));
struct EpiProj {
    static constexpr bool PERM = true, AFTER_DRAIN = false;
    bf16_t* O; int ldc; const PG8_LAS float* rs;
    __device__ __forceinline__ void operator()(const f32x4 (&acc)[2][2][4][2], const Unit& u, int wr, int wc, int fr, int fq) const {
        const int rl0 = wr * 64 + fr, col0 = u.pn * BM + wc * 32 + 8 * fq;
#pragma unroll
        for (int ai = 0; ai < 2; ++ai)
#pragma unroll
            for (int m = 0; m < 4; ++m) { const int rl = rl0 + ai * HALF + m * 16; const float s = rs[u.idx * 256 + rl];
                bf16_t* rowp = O + (size_t)(u.pm * BM + rl) * ldc + col0;
#pragma unroll
                for (int bj = 0; bj < 2; ++bj) { const f32x4 v0 = acc[ai][bj][m][0] * s, v1 = acc[ai][bj][m][1] * s;
                    u32x4 w; w.x = cvt_pk_bf16(v0[0], v0[1]); w.y = cvt_pk_bf16(v0[2], v0[3]); w.z = cvt_pk_bf16(v1[0], v1[1]); w.w = cvt_pk_bf16(v1[2], v1[3]);
                    *(u32x4*)(rowp + bj * HALF) = w; } }
    }
};
struct EpiSwiGLU {
    static constexpr bool PERM = true, AFTER_DRAIN = false;
    bf16_t* O; int ldc; const PG8_LAS float* rs;
    __device__ __forceinline__ void operator()(const f32x4 (&acc)[2][2][4][2], const Unit& u, int wr, int wc, int fr, int fq) const {
        const int rl0 = wr * 64 + fr, col0 = u.pn * HALF + wc * 32 + 8 * fq;
#pragma unroll
        for (int ai = 0; ai < 2; ++ai)
#pragma unroll
            for (int m = 0; m < 4; ++m) { const int rl = rl0 + ai * HALF + m * 16; const float s = rs[u.idx * 256 + rl];
                float o[8];
#pragma unroll
                for (int n = 0; n < 2; ++n)
#pragma unroll
                    for (int e = 0; e < 4; ++e) { const float g = acc[ai][0][m][n][e] * s, up = acc[ai][1][m][n][e] * s; o[n * 4 + e] = g * __builtin_amdgcn_rcpf(1.f + __expf(-g)) * up; }
                u32x4 w; w.x = cvt_pk_bf16(o[0], o[1]); w.y = cvt_pk_bf16(o[2], o[3]); w.z = cvt_pk_bf16(o[4], o[5]); w.w = cvt_pk_bf16(o[6], o[7]);
                *(u32x4*)(O + (size_t)(u.pm * BM + rl) * ldc + col0) = w; }
    }
};
struct EpiResid {
    static constexpr bool PERM = true, AFTER_DRAIN = false;
    float* hmain; float* hmeta; bf16_t* hb; float* ssq;
    __device__ __forceinline__ void operator()(const f32x4 (&acc)[2][2][4][2], const Unit& u, int wr, int wc, int fr, int fq) const {
        float* hbase = (u.pm < 64) ? hmain : hmeta - (size_t)16384 * 1024;
        const int col0 = u.pn * BM + wc * 32 + 8 * fq;
#pragma unroll
        for (int ai = 0; ai < 2; ++ai)
#pragma unroll
            for (int m = 0; m < 4; ++m) { const int row = u.pm * BM + ai * HALF + wr * 64 + m * 16 + fr; float sq = 0.f;
#pragma unroll
                for (int bj = 0; bj < 2; ++bj) { const size_t off = (size_t)row * 1024 + col0 + bj * HALF;
                    f32x4 h0 = *(const f32x4*)(hbase + off), h1 = *(const f32x4*)(hbase + off + 4);
                    h0 = h0 + acc[ai][bj][m][0]; h1 = h1 + acc[ai][bj][m][1]; *(f32x4*)(hbase + off) = h0; *(f32x4*)(hbase + off + 4) = h1;
                    sq += ((h0[0] * h0[0] + h0[1] * h0[1]) + (h0[2] * h0[2] + h0[3] * h0[3])) + ((h1[0] * h1[0] + h1[1] * h1[1]) + (h1[2] * h1[2] + h1[3] * h1[3]));
                    u32x4 w; w.x = cvt_pk_bf16(h0[0], h0[1]); w.y = cvt_pk_bf16(h0[2], h0[3]); w.z = cvt_pk_bf16(h1[0], h1[1]); w.w = cvt_pk_bf16(h1[2], h1[3]); *(u32x4*)(hb + off) = w; }
                sq += __shfl_xor(sq, 16); sq += __shfl_xor(sq, 32);
                if (fq == 0) ssq[(size_t)row * 16 + u.pn * 4 + wc] = sq; }
    }
};

template <class Epi, class Sched, bool ALIGN_EPI = false, bool SP2 = false>
__device__ __forceinline__ void gemm_phase(PG8_LAS unsigned char* lds, const Gemm g, const Sched& S, const Epi& E) {
    int tid_ = threadIdx.x; asm volatile("" : "+v"(tid_)); const int tid = tid_, wid = __builtin_amdgcn_readfirstlane(tid >> 6), lane = tid & 63, wr = wid >> 2, wc = wid & 3, fr = lane & 15, fq = lane >> 4;
    const int K = g.K, nt = K / BK;
    unsigned voffA[2], voffB[2];
#pragma unroll
    for (int i = 0; i < 2; ++i) { int R, C; stage_rc(tid * 16 + i * 8192, R, C); const int Rb = Epi::PERM ? ((R & ~31) + perm32(R & 31)) : R;
        voffA[i] = (unsigned)(R * K + C) * 2u; voffB[i] = (unsigned)(Rb * K + C) * 2u; }
    const size_t kstep = (size_t)(BK * 2);
    const size_t hstep = (size_t)HALF * K * 2;
    const size_t tstep = 2 * hstep;
    const unsigned ldsw = (unsigned)wid * 1024u;
    const int aoff = lds_byte(wr * 64 + fr, fq * 8), boff = lds_byte(wc * 32 + fr, fq * 8);
#define PG8_SA(b, h) (((b) * 2 + (h)) * HTB)
#define PG8_SB(b, h) ((4 + (b) * 2 + (h)) * HTB)
#define PG8_STAGE(bufoff, gbase, voff) do { _Pragma("unroll") for (int _i = 0; _i < 2; ++_i) \
        __builtin_amdgcn_global_load_lds((const unsigned*)((const char*)(gbase) + (voff)[_i]), (PG8_LAS unsigned*)(lds + (bufoff) + ldsw + _i * 8192), 16, 0, 0); } while (0)
#define PG8_LDA(dst, b, h) do { _Pragma("unroll") for (int m = 0; m < 4; ++m) _Pragma("unroll") for (int k = 0; k < 2; ++k) dst[m][k] = *(const PG8_LAS bf16x8*)(lds + PG8_SA(b, h) + aoff + m * 2048 + k * 1024); } while (0)
#define PG8_LDB(dst, b, h) do { _Pragma("unroll") for (int n = 0; n < 2; ++n) _Pragma("unroll") for (int k = 0; k < 2; ++k) dst[n][k] = *(const PG8_LAS bf16x8*)(lds + PG8_SB(b, h) + boff + n * 2048 + k * 1024); } while (0)
#define PG8_MMA(ai, bj, At, Bt) do { __builtin_amdgcn_s_setprio(1); _Pragma("unroll") for (int m = 0; m < 4; ++m) _Pragma("unroll") for (int n = 0; n < 2; ++n) _Pragma("unroll") for (int k = 0; k < 2; ++k) \
        acc[ai][bj][m][n] = __builtin_amdgcn_mfma_f32_16x16x32_bf16(Bt[n][k], At[m][k], acc[ai][bj][m][n], 0, 0, 0); __builtin_amdgcn_s_setprio(0); } while (0)
#define PG8_WAIT_V(n) asm volatile("s_waitcnt vmcnt(" #n ")" ::: "memory")
#define PG8_WAIT_L(n) asm volatile("s_waitcnt lgkmcnt(" #n ")" ::: "memory")
#define PG8_BAR __builtin_amdgcn_s_barrier()
#define PG8_SCHED __builtin_amdgcn_sched_barrier(0)
    Unit cur, nxt; int ui = 0;
    if (!S.next(0, cur)) return;
    f32x4 acc[2][2][4][2];
#pragma unroll
    for (int a = 0; a < 2; ++a)
#pragma unroll
        for (int b = 0; b < 2; ++b)
#pragma unroll
            for (int m = 0; m < 4; ++m)
#pragma unroll
                for (int n = 0; n < 2; ++n) acc[a][b][m][n] = (f32x4){0.f, 0.f, 0.f, 0.f};
    bf16x8 At[4][2], B0[2][2], B1[2][2];
    const char* cA = (const char*)g.A + (size_t)cur.pm * tstep; const char* cB = (const char*)g.Bt + (size_t)cur.pn * tstep;
    S.a_ready(cur);
    if constexpr (SP2) {
        PG8_STAGE(PG8_SB(0, 0), cB, voffB); PG8_STAGE(PG8_SB(0, 1), cB + hstep, voffB); PG8_STAGE(PG8_SA(0, 0), cA, voffA); PG8_STAGE(PG8_SA(0, 1), cA + hstep, voffA);
        if (wr == 1) PG8_BAR;
        PG8_WAIT_V(2); PG8_BAR;
        PG8_STAGE(PG8_SB(1, 0), cB + kstep, voffB); PG8_STAGE(PG8_SA(1, 0), cA + kstep, voffA); PG8_STAGE(PG8_SB(1, 1), cB + hstep + kstep, voffB);
        PG8_WAIT_V(6); PG8_BAR;
    } else {
        PG8_STAGE(PG8_SB(0, 0), cB, voffB); PG8_STAGE(PG8_SA(0, 0), cA, voffA); PG8_STAGE(PG8_SB(0, 1), cB + hstep, voffB); PG8_STAGE(PG8_SA(0, 1), cA + hstep, voffA);
        if (wr == 1) PG8_BAR;
        PG8_WAIT_V(4); PG8_BAR;
        PG8_STAGE(PG8_SB(1, 0), cB + kstep, voffB); PG8_STAGE(PG8_SA(1, 0), cA + kstep, voffA); PG8_STAGE(PG8_SB(1, 1), cB + hstep + kstep, voffB);
        PG8_WAIT_V(6); PG8_BAR;
    }
    for (;;) {
        const bool has_next = S.next(ui + 1, nxt);
        const char* nA = has_next ? (const char*)g.A + (size_t)nxt.pm * tstep : cA; const char* nB = has_next ? (const char*)g.Bt + (size_t)nxt.pn * tstep : cB;
        for (int t = 0; t < nt; t += 2) {
            const bool last = (t == nt - 2);
            const char* a1 = cA + (size_t)(t + 1) * kstep;
            const char* a2 = last ? nA : cA + (size_t)(t + 2) * kstep; const char* b2 = last ? nB : cB + (size_t)(t + 2) * kstep;
            const char* a3 = a2 + kstep; const char* b3 = b2 + kstep;
            if (last && has_next) S.a_ready(nxt);
            if constexpr (SP2) {
            PG8_LDB(B0, 0, 0); PG8_LDB(B1, 0, 1); PG8_SCHED; PG8_LDA(At, 0, 0); PG8_STAGE(PG8_SA(1, 1), a1 + hstep, voffA);
            PG8_WAIT_V(8); PG8_WAIT_L(0); PG8_BAR; PG8_MMA(0, 0, At, B0); PG8_MMA(0, 1, At, B1); PG8_BAR; PG8_SCHED;
            PG8_LDA(At, 0, 1); PG8_STAGE(PG8_SB(0, 0), b2, voffB); PG8_STAGE(PG8_SB(0, 1), b2 + hstep, voffB); PG8_STAGE(PG8_SA(0, 0), a2, voffA);
            PG8_WAIT_V(8); PG8_WAIT_L(0); PG8_BAR; PG8_MMA(1, 0, At, B0); PG8_MMA(1, 1, At, B1); PG8_BAR; PG8_SCHED;
            PG8_LDB(B0, 1, 0); PG8_LDB(B1, 1, 1); PG8_SCHED; PG8_LDA(At, 1, 0); PG8_STAGE(PG8_SA(0, 1), a2 + hstep, voffA);
            PG8_WAIT_V(8); PG8_WAIT_L(0); PG8_BAR; PG8_MMA(0, 0, At, B0); PG8_MMA(0, 1, At, B1); PG8_BAR; PG8_SCHED;
            PG8_LDA(At, 1, 1); PG8_STAGE(PG8_SB(1, 0), b3, voffB); PG8_STAGE(PG8_SB(1, 1), b3 + hstep, voffB); PG8_STAGE(PG8_SA(1, 0), a3, voffA);
            PG8_WAIT_V(8); PG8_WAIT_L(0); PG8_BAR; PG8_MMA(1, 0, At, B0); PG8_MMA(1, 1, At, B1); PG8_BAR; PG8_SCHED;
            } else {
            PG8_LDB(B0, 0, 0); PG8_SCHED; PG8_LDA(At, 0, 0); PG8_STAGE(PG8_SA(1, 1), a1 + hstep, voffA);
            PG8_WAIT_L(8); PG8_BAR; PG8_WAIT_L(0); PG8_MMA(0, 0, At, B0); PG8_BAR; PG8_SCHED;
            PG8_LDB(B1, 0, 1); PG8_STAGE(PG8_SB(0, 0), b2, voffB);
            PG8_BAR; PG8_WAIT_L(0); PG8_MMA(0, 1, At, B1); PG8_BAR;
            PG8_LDA(At, 0, 1); PG8_STAGE(PG8_SA(0, 0), a2, voffA);
            PG8_BAR; PG8_WAIT_L(0); PG8_MMA(1, 0, At, B0); PG8_BAR; PG8_SCHED;
            PG8_STAGE(PG8_SB(0, 1), b2 + hstep, voffB);
            PG8_WAIT_V(6); PG8_BAR; PG8_MMA(1, 1, At, B1); PG8_BAR;
            PG8_LDB(B0, 1, 0); PG8_SCHED; PG8_LDA(At, 1, 0); PG8_STAGE(PG8_SA(0, 1), a2 + hstep, voffA);
            PG8_WAIT_L(8); PG8_BAR; PG8_WAIT_L(0); PG8_MMA(0, 0, At, B0); PG8_BAR; PG8_SCHED;
            PG8_LDB(B1, 1, 1); PG8_STAGE(PG8_SB(1, 0), b3, voffB);
            PG8_BAR; PG8_WAIT_L(0); PG8_MMA(0, 1, At, B1); PG8_BAR;
            PG8_LDA(At, 1, 1); PG8_STAGE(PG8_SA(1, 0), a3, voffA);
            PG8_BAR; PG8_WAIT_L(0); PG8_MMA(1, 0, At, B0); PG8_BAR; PG8_SCHED;
            PG8_STAGE(PG8_SB(1, 1), b3 + hstep, voffB);
            PG8_WAIT_V(6); PG8_BAR; PG8_MMA(1, 1, At, B1); PG8_BAR;
            }
        }
        if constexpr (ALIGN_EPI) { if (wr == 0) PG8_BAR; }
        if constexpr (!Epi::AFTER_DRAIN) { E(acc, cur, wr, wc, fr, fq); S.done(cur); }
        if (!has_next) break;
#pragma unroll
        for (int a = 0; a < 2; ++a)
#pragma unroll
            for (int b = 0; b < 2; ++b)
#pragma unroll
                for (int m = 0; m < 4; ++m)
#pragma unroll
                    for (int n = 0; n < 2; ++n) acc[a][b][m][n] = (f32x4){0.f, 0.f, 0.f, 0.f};
        cur = nxt; cA = nA; cB = nB; ++ui;
        if constexpr (ALIGN_EPI) { if (wr == 1) PG8_BAR; }
    }
    PG8_WAIT_V(0);
    if constexpr (!ALIGN_EPI) { if (wr == 0) PG8_BAR; }
    PG8_BAR;
    if constexpr (Epi::AFTER_DRAIN) { E.fused(acc, cur, wr, wc, fr, fq, lds, wid, lane); S.done(cur); }
#undef PG8_SA
#undef PG8_SB
#undef PG8_STAGE
#undef PG8_LDA
#undef PG8_LDB
#undef PG8_MMA
#undef PG8_WAIT_V
#undef PG8_WAIT_L
#undef PG8_BAR
#undef PG8_SCHED
}
}
#define LAS __attribute__((address_space(3)))
typedef unsigned short bf16;
typedef short bf16x8 __attribute__((ext_vector_type(8)));
typedef float f32x4 __attribute__((ext_vector_type(4)));
typedef unsigned u32x4 __attribute__((ext_vector_type(4)));
typedef unsigned u32x2 __attribute__((ext_vector_type(2)));

constexpr int DM = 1024, SEQ = 16384, LTOK = 16400, RPAD = 16640, DEPTH = 4;
constexpr int NPROJ = 3072, DIN = 3080, DFF = 2816, NGU = 5632;
constexpr int NTASK = 1028;
constexpr int NSCAN = 32;
constexpr int CT = 66, NCT = 249;
constexpr size_t MiB = 1u << 20;
constexpr size_t WS_WBA = 1 * MiB, WS_GL = 1 * MiB + 256 * 1024, WS_SSQ = 2 * MiB, WS_HMETA = 3 * MiB + 512 * 1024;
constexpr size_t WS_WIN = 5 * MiB, WS_WOUT = 11 * MiB, WS_WGU = 13 * MiB, WS_WDN = 24 * MiB, WS_HB = 30 * MiB, WS_PROJ = 63 * MiB;
constexpr size_t WS_Y = 161 * MiB, WS_MP = 194 * MiB, WS_NL = 227 * MiB, WS_QP = 260 * MiB, WS_O0 = 277 * MiB, WS_SIMG = 294 * MiB, WS_BG = 328 * MiB, WS_MG = 329 * MiB, WS_NG = 332 * MiB, WS_GG = 335 * MiB, WS_WBAB = 336 * MiB, WS_END = 337 * MiB;
constexpr int LDS_BYTES = 147456, RS_OFF = 131072 + 512;

struct Params { const float* in[17]; float* out; unsigned char* ws; };
typedef const __attribute__((address_space(4))) Params* KP;
__device__ __forceinline__ Params load_params(KP kp) {
    Params P{};
#if defined(__HIP_DEVICE_COMPILE__)
    asm volatile("" : "+s"(kp));
#pragma unroll
    for (int i = 0; i < 17; ++i) P.in[i] = kp->in[i];
    P.out = kp->out; P.ws = kp->ws;
#endif
    return P;
}
#define LOAD_PARAMS(kp) const Params P = load_params(kp)

__device__ __forceinline__ int bidx() { int b = blockIdx.x; asm volatile("" : "+s"(b)); return b; }
constexpr int GRID = 256;
__device__ __forceinline__ float bf2f(unsigned v) { return __uint_as_float(v << 16); }
__device__ __forceinline__ float bflo(unsigned v) { return __uint_as_float(v << 16); }
__device__ __forceinline__ float bfhi(unsigned v) { return __uint_as_float(v & 0xffff0000u); }
typedef __bf16 bf16x2_t __attribute__((ext_vector_type(2)));
__device__ __forceinline__ unsigned pk2(float lo, float hi) { bf16x2_t v = {(__bf16)lo, (__bf16)hi}; return __builtin_bit_cast(unsigned, v); }
__device__ __forceinline__ unsigned f2bf(float f) { return pk2(f, f) & 0xffffu; }
__device__ __forceinline__ f32x4 mfma16(bf16x8 a, bf16x8 b, f32x4 c) { return __builtin_amdgcn_mfma_f32_16x16x32_bf16(a, b, c, 0, 0, 0); }
__device__ __forceinline__ float sigm(float x) { return __builtin_amdgcn_rcpf(1.f + __expf(-x)); }
__device__ __forceinline__ float silu(float x) { return x * sigm(x); }
__device__ __forceinline__ float sum8(float v) { v += __int_as_float(__builtin_amdgcn_update_dpp(0, __float_as_int(v), 0xB1, 0xf, 0xf, false)); v += __int_as_float(__builtin_amdgcn_update_dpp(0, __float_as_int(v), 0x4E, 0xf, 0xf, false));
    v += __int_as_float(__builtin_amdgcn_update_dpp(0, __float_as_int(v), 0x141, 0xf, 0xf, false)); return v; }
__device__ __forceinline__ float wave_sum(float v) {
#pragma unroll
    for (int o = 1; o < 64; o <<= 1) v += __shfl_xor(v, o);
    return v;
}
__device__ __forceinline__ float wave_tr_reduce64(float (&v)[64], int lane) {
#pragma unroll
    for (int off = 32; off >= 1; off >>= 1) {
        const bool hi = (lane & off) != 0;
#pragma unroll
        for (int i = 0; i < off; ++i) {
            const float send = hi ? v[i] : v[i + off];
            const float keep = hi ? v[i + off] : v[i];
            v[i] = keep + __shfl_xor(send, off);
        }
    }
    return v[0];
}
__device__ __forceinline__ int pos_row(int p) { return p < 16 ? SEQ + p : p - 16; }
__device__ __forceinline__ int chunk_row(int c, int tok) { return c == 0 ? (tok < 48 ? -1 : SEQ + tok - 48) : 64 * (c - 1) + tok; }

__device__ __forceinline__ void conv_item(const float* __restrict__ W, int Nsrc, int srccol0, const float* __restrict__ scale, bf16* WT, int K, int drow0, int k0, LAS float* scr, int lane) {
    float wv[32];
#pragma unroll
    for (int i = 0; i < 32; ++i) { const int kk = 2 * i + (lane >> 5); wv[i] = W[(size_t)(k0 + kk) * Nsrc + srccol0 + (lane & 31)]; }
    if (scale) {
#pragma unroll
        for (int i = 0; i < 32; ++i) wv[i] *= scale[k0 + 2 * i + (lane >> 5)]; }
#pragma unroll
    for (int i = 0; i < 32; ++i) { const int kk = 2 * i + (lane >> 5); scr[kk * 33 + (lane & 31)] = wv[i]; }
    asm volatile("s_waitcnt lgkmcnt(0)" ::: "memory");
    const int c = lane & 7;
#pragma unroll
    for (int j = 0; j < 4; ++j) { const int n = (lane >> 3) + 8 * j; const LAS float* s = scr + (8 * c) * 33 + n;
        u32x4 o; o.x = pk2(s[0 * 33], s[1 * 33]); o.y = pk2(s[2 * 33], s[3 * 33]); o.z = pk2(s[4 * 33], s[5 * 33]); o.w = pk2(s[6 * 33], s[7 * 33]);
        *(u32x4*)(WT + (size_t)(drow0 + n) * K + k0 + 8 * c) = o; }
    asm volatile("s_waitcnt lgkmcnt(0)" ::: "memory");
}
__device__ __forceinline__ void conv_weight_items(int kind, int l, const Params& P, LAS float* scr, int gw, int ngw, int lane) {
    unsigned char* ws = P.ws;
    if (kind == 0) { const float* W = P.in[3] + (size_t)l * DM * DIN; const float* sc = P.in[2] + l * DM; bf16* WT = (bf16*)(ws + WS_WIN);
        for (int it = gw; it < 16 * 96; it += ngw) { const int kb = it / 96, nb = it % 96; conv_item(W, DIN, 32 * nb, sc, WT, DM, 32 * nb, 64 * kb, scr, lane); } }
    else if (kind == 1) { const float* W = P.in[12] + (size_t)l * DM * DM; bf16* WT = (bf16*)(ws + WS_WOUT);
        for (int it = gw; it < 16 * 32; it += ngw) { const int kb = it / 32, nb = it % 32; conv_item(W, DM, 32 * nb, nullptr, WT, DM, 32 * nb, 64 * kb, scr, lane); } }
    else if (kind == 2) { const float* W = P.in[14] + (size_t)l * DM * NGU; const float* sc = P.in[13] + l * DM; bf16* WT = (bf16*)(ws + WS_WGU);
        for (int it = gw; it < 16 * 176; it += ngw) { const int kb = it / 176, nb = it % 176; const int d0 = 32 * nb, pn = d0 >> 8, j0 = d0 & 255;
            const int src = j0 < 128 ? 128 * pn + j0 : DFF + 128 * pn + (j0 - 128); conv_item(W, NGU, src, sc, WT, DM, d0, 64 * kb, scr, lane); } }
    else { const float* W = P.in[15] + (size_t)l * DFF * DM; bf16* WT = (bf16*)(ws + WS_WDN);
        for (int it = gw; it < 44 * 32; it += ngw) { const int kb = it / 32, nb = it % 32; conv_item(W, DM, 32 * nb, nullptr, WT, DFF, 32 * nb, 64 * kb, scr, lane); } }
}

template <class Sched> __device__ __forceinline__ void fill_rstd(LAS float* rs, const Sched& S, const float* ssq) {
    LAS int* upm = (LAS int*)(rs + 6 * 256);
    if (threadIdx.x < 6) { pg8::Unit u; upm[threadIdx.x] = S.next((int)threadIdx.x, u) ? u.pm : -1; }
    __syncthreads();
    if (threadIdx.x < 256) { f32x4 v[6][4];
#pragma unroll
        for (int i = 0; i < 6; ++i) { const int pm = upm[i]; const f32x4* p = (const f32x4*)(ssq + (size_t)((pm < 0 ? 0 : pm) * 256 + threadIdx.x) * 16); v[i][0] = p[0]; v[i][1] = p[1]; v[i][2] = p[2]; v[i][3] = p[3]; }
#pragma unroll
        for (int i = 0; i < 6; ++i) { const f32x4 a = v[i][0], b = v[i][1], c = v[i][2], d = v[i][3];
            const float s = ((a[0] + a[1]) + (a[2] + a[3])) + ((b[0] + b[1]) + (b[2] + b[3])) + ((c[0] + c[1]) + (c[2] + c[3])) + ((d[0] + d[1]) + (d[2] + d[3]));
            rs[i * 256 + threadIdx.x] = rsqrtf(s * (1.f / 1024.f) + 1e-6f); } }
    __syncthreads();
}

__device__ __forceinline__ void prologue_phase(LAS unsigned char* lds, KP kp) {
    LOAD_PARAMS(kp);
    int tid_ = threadIdx.x; asm volatile("" : "+v"(tid_)); const int tid = tid_, lane = tid & 63, wave = tid >> 6, gw = bidx() * 8 + wave, ngw = GRID * 8;
    unsigned char* ws = P.ws;
    conv_weight_items(0, 0, P, (LAS float*)(lds + wave * 8448), gw, ngw, lane);
    { float* wba = (float*)(ws + WS_WBA);
      for (int i = bidx() * 512 + tid; i < DEPTH * 8 * DM; i += GRID * 512) { const int l = i >> 13, j = (i >> 10) & 7, k = i & 1023;
          wba[i] = P.in[3][((size_t)l * DM + k) * DIN + NPROJ + j] * P.in[2][l * DM + k]; } }
    { bf16* wbab = (bf16*)(ws + WS_WBAB);
      for (int i = bidx() * 512 + tid; i < DEPTH * 16 * DM; i += GRID * 512) { const int l = i >> 14, j = (i >> 10) & 15, k = i & 1023;
          const float wv = P.in[3][((size_t)l * DM + k) * DIN + NPROJ + (j & 7)] * P.in[2][l * DM + k]; const unsigned hi = f2bf(wv);
          wbab[i] = j < 8 ? (bf16)hi : (bf16)f2bf(wv - bf2f(hi)); } }
    { float* hmeta = (float*)(ws + WS_HMETA); bf16* hb = (bf16*)(ws + WS_HB); float* ssq = (float*)(ws + WS_SSQ);
      for (int row = gw; row < RPAD; row += ngw) {
          const float* src = row < SEQ ? P.in[0] + (size_t)row * DM : (row < LTOK ? P.in[1] + (size_t)(row - SEQ) * DM : nullptr);
          float* dst = row < SEQ ? P.out + (size_t)row * DM : hmeta + (size_t)(row - SEQ) * DM; float s = 0.f;
#pragma unroll
          for (int j = 0; j < 4; ++j) { f32x4 v = {0.f, 0.f, 0.f, 0.f}; if (src) v = ((const f32x4*)src)[lane + 64 * j]; ((f32x4*)dst)[lane + 64 * j] = v;
              s += (v[0] * v[0] + v[1] * v[1]) + (v[2] * v[2] + v[3] * v[3]); u32x2 w; w.x = pk2(v[0], v[1]); w.y = pk2(v[2], v[3]); ((u32x2*)(hb + (size_t)row * DM))[lane + 64 * j] = w; }
          s = wave_sum(s); if (lane < 16) ssq[(size_t)row * 16 + lane] = lane == 0 ? s : 0.f; } }
}

__device__ __forceinline__ void prep_phase(LAS unsigned char* lds, int l, KP kp) {
    LOAD_PARAMS(kp);
    int tid_ = threadIdx.x; asm volatile("" : "+v"(tid_)); const int tid = tid_, lane = tid & 63, wave = tid >> 6, r = lane & 15, q = lane >> 4;
    unsigned char* ws = P.ws;
    const bf16* proj = (const bf16*)(ws + WS_PROJ);
    const float* bg = (const float*)(ws + WS_BG); float* glast = (float*)(ws + WS_GL);
    bf16* Mp = (bf16*)(ws + WS_MP); bf16* Nl = (bf16*)(ws + WS_NL); bf16* Qp = (bf16*)(ws + WS_QP); bf16* O0 = (bf16*)(ws + WS_O0);
    LAS bf16* qs = (LAS bf16*)(lds + 0); LAS bf16* ks = (LAS bf16*)(lds + 17408); LAS bf16* rhsT = (LAS bf16*)(lds + 34816);
    LAS bf16* kdT = (LAS bf16*)(lds + 71680); LAS bf16* uwT = (LAS bf16*)(lds + 90112);
    LAS float* Am = (LAS float*)(lds + 90112); LAS float* TT = (LAS float*)(lds + 107520);
    LAS bf16* Tb = (LAS bf16*)(lds + 126976); LAS bf16* attn = (LAS bf16*)(lds + 136192);
    LAS float* gcs = (LAS float*)(lds + 145408); LAS float* betas = gcs + 64; LAS float* egc = gcs + 128; LAS float* red = gcs + 192; LAS float* redk = gcs + 320;
    for (int task = bidx(); task < NTASK; task += GRID) {
        const int c = task >> 2, h = task & 3;
        const int d = tid & 127, tq = tid >> 7, pbase = 64 * c - 48 + 16 * tq;
        unsigned short raw[3][19];
#pragma unroll
        for (int which = 0; which < 3; ++which)
#pragma unroll
            for (int t = 0; t < 19; ++t) { const int p = pbase + t - 3; raw[which][t] = proj[(size_t)pos_row(p < 0 ? 0 : p) * NPROJ + 1024 + which * 512 + h * 128 + d]; }
        if (wave == 0) { const int row = chunk_row(c, lane); float beta = 0.f, g = 0.f; if (row >= 0) { beta = bg[(size_t)row * 8 + h]; g = bg[(size_t)row * 8 + 4 + h]; }
#pragma unroll
            for (int off = 1; off < 64; off <<= 1) { const float t = __shfl_up(g, off); if (lane >= off) g += t; }
            gcs[lane] = g; egc[lane] = expf(g); betas[lane] = beta; if (lane == 63) glast[task] = expf(g); }
        __syncthreads();
        { const float gl = gcs[63]; float valq[16], valk[16];
#define PB_CONV(which_, val_) do { const float* cw = P.in[8] + (size_t)l * 4 * 1536 + (which_) * 512 + h * 128 + d; \
            const float w0 = cw[0], w1 = cw[1536], w2 = cw[3072], w3 = cw[4608]; float x0 = 0.f, x1 = 0.f, x2 = 0.f; \
            _Pragma("unroll") for (int t = -3; t < 16; ++t) { const int p = pbase + t; const float xv = p >= 0 ? bf2f(raw[which_][t + 3]) : 0.f; \
                if (t >= 0) { const float y = (w0 * x0 + w1 * x1) + (w2 * x2 + w3 * xv); val_[t] = silu(y); } \
                x0 = x1; x1 = x2; x2 = xv; } } while (0)
#define PB_RED(val_, red_) do { float sq[8]; \
            _Pragma("unroll") for (int i = 0; i < 8; ++i) { const bool hi = (lane & 32) != 0; const float a = val_[i] * val_[i], bq = val_[i + 8] * val_[i + 8]; sq[i] = (hi ? bq : a) + __shfl_xor(hi ? a : bq, 32); } \
            _Pragma("unroll") for (int i = 0; i < 4; ++i) { const bool hi = (lane & 16) != 0; sq[i] = (hi ? sq[i + 4] : sq[i]) + __shfl_xor(hi ? sq[i] : sq[i + 4], 16); } \
            _Pragma("unroll") for (int i = 0; i < 2; ++i) { const bool hi = (lane & 8) != 0; sq[i] = (hi ? sq[i + 2] : sq[i]) + __shfl_xor(hi ? sq[i] : sq[i + 2], 8); } \
            { const bool hi = (lane & 4) != 0; sq[0] = (hi ? sq[1] : sq[0]) + __shfl_xor(hi ? sq[0] : sq[1], 4); } \
            sq[0] += __shfl_xor(sq[0], 1); sq[0] += __shfl_xor(sq[0], 2); \
            if ((lane & 3) == 0) red_[(wave & 1) * 64 + 16 * tq + (lane >> 2)] = sq[0]; } while (0)
          PB_CONV(0, valq); PB_RED(valq, red);
          PB_CONV(1, valk); PB_RED(valk, redk);
          { float bv[16]; PB_CONV(2, bv);
#pragma unroll
            for (int t = 0; t < 16; ++t) bv[t] *= betas[16 * tq + t];
            u32x4 o; o.x = pk2(bv[0], bv[1]); o.y = pk2(bv[2], bv[3]); o.z = pk2(bv[4], bv[5]); o.w = pk2(bv[6], bv[7]); *(LAS u32x4*)(rhsT + d * 72 + 16 * tq) = o;
            o.x = pk2(bv[8], bv[9]); o.y = pk2(bv[10], bv[11]); o.z = pk2(bv[12], bv[13]); o.w = pk2(bv[14], bv[15]); *(LAS u32x4*)(rhsT + d * 72 + 16 * tq + 8) = o; }
          __syncthreads();
#pragma unroll
          for (int t = 0; t < 16; ++t) { const int tk = 16 * tq + t; const float n = rsqrtf(red[tk] + red[64 + tk] + 1e-6f) * 0.08838834764831845f; qs[tk * 136 + d] = (bf16)f2bf(valq[t] * n); }
          { float kd[16], kw[16];
#pragma unroll
            for (int t = 0; t < 16; ++t) { const int tk = 16 * tq + t; const float n = rsqrtf(redk[tk] + redk[64 + tk] + 1e-6f); const float kv = valk[t] * n;
                ks[tk * 136 + d] = (bf16)f2bf(kv); kd[t] = kv * __expf(gl - gcs[tk]); kw[t] = kv * betas[tk] * egc[tk]; }
            u32x4 o; o.x = pk2(kd[0], kd[1]); o.y = pk2(kd[2], kd[3]); o.z = pk2(kd[4], kd[5]); o.w = pk2(kd[6], kd[7]); *(LAS u32x4*)(kdT + d * 72 + 16 * tq) = o;
            o.x = pk2(kd[8], kd[9]); o.y = pk2(kd[10], kd[11]); o.z = pk2(kd[12], kd[13]); o.w = pk2(kd[14], kd[15]); *(LAS u32x4*)(kdT + d * 72 + 16 * tq + 8) = o;
            o.x = pk2(kw[0], kw[1]); o.y = pk2(kw[2], kw[3]); o.z = pk2(kw[4], kw[5]); o.w = pk2(kw[6], kw[7]); *(LAS u32x4*)(rhsT + (128 + d) * 72 + 16 * tq) = o;
            o.x = pk2(kw[8], kw[9]); o.y = pk2(kw[10], kw[11]); o.z = pk2(kw[12], kw[13]); o.w = pk2(kw[14], kw[15]); *(LAS u32x4*)(rhsT + (128 + d) * 72 + 16 * tq + 8) = o; }
#undef PB_CONV
#undef PB_RED
        }
        __syncthreads();
        for (int tt = wave; tt < 32; tt += 8) { const int kind = tt >> 4, tile = tt & 15, mt = tile >> 2, nt = tile & 3;
            if (nt > mt) { if (kind == 1) {
#pragma unroll
                    for (int j = 0; j < 4; ++j) attn[(16 * mt + 4 * q + j) * 72 + 16 * nt + r] = 0; }
                continue; }
            const LAS bf16* X = kind ? qs : ks; f32x4 acc = {0.f, 0.f, 0.f, 0.f};
#pragma unroll
            for (int s = 0; s < 4; ++s) { const bf16x8 a = *(const LAS bf16x8*)(X + (16 * mt + r) * 136 + 32 * s + 8 * q), b = *(const LAS bf16x8*)(ks + (16 * nt + r) * 136 + 32 * s + 8 * q); acc = mfma16(a, b, acc); }
#pragma unroll
            for (int j = 0; j < 4; ++j) { const int cc = 16 * mt + 4 * q + j, ss = 16 * nt + r; const float dec = __expf(gcs[cc] - gcs[ss]);
                if (kind == 0) Am[cc * 68 + ss] = (ss < cc) ? betas[cc] * acc[j] * dec : 0.f;
                else attn[cc * 72 + ss] = (bf16)f2bf((ss <= cc) ? acc[j] * dec : 0.f); } }
        __syncthreads();
        { for (int e = tid; e < 64 * 68; e += 512) TT[e] = 0.f; }
        __syncthreads();
        if (tid < 64) { const int j = tid, b16 = j & ~15, jl = j & 15; float tcol[16];
#pragma unroll
            for (int i = 0; i < 16; ++i) tcol[i] = (i == jl) ? 1.f : 0.f;
#pragma unroll
            for (int i = 1; i < 16; ++i) { float acc = 0.f;
#pragma unroll
                for (int s4 = 0; s4 < (i + 3) / 4; ++s4) { f32x4 av = *(const LAS f32x4*)(Am + (b16 + i) * 68 + b16 + 4 * s4);
#pragma unroll
                    for (int e = 0; e < 4; ++e) if (4 * s4 + e < i) acc += av[e] * tcol[4 * s4 + e]; }
                float tn = (i > jl) ? -acc : tcol[i]; asm volatile("" : "+v"(tn) :: "memory"); tcol[i] = tn; }
#pragma unroll
            for (int i4 = 0; i4 < 4; ++i4) { f32x4 o = {tcol[4 * i4], tcol[4 * i4 + 1], tcol[4 * i4 + 2], tcol[4 * i4 + 3]}; *(LAS f32x4*)(TT + j * 68 + b16 + 4 * i4) = o; } }
        __syncthreads();
        { LAS float* tmpb = (LAS float*)Tb;
#pragma unroll 1
          for (int dd = 1; dd < 4; ++dd) { const int nel = (4 - dd) * 256;
              for (int e = tid; e < nel; e += 512) { const int blk = e >> 8, i = (e >> 4) & 15, j = e & 15, bi = blk + dd, bj = blk; float acc = 0.f;
                  const LAS float* ar = Am + (16 * bi + i) * 68; const LAS float* tr = TT + (16 * bj + j) * 68;
#pragma unroll 4
                  for (int s4 = 4 * bj; s4 < 4 * bi; ++s4) { const f32x4 av = *(const LAS f32x4*)(ar + 4 * s4), tv = *(const LAS f32x4*)(tr + 4 * s4); acc += (av[0] * tv[0] + av[1] * tv[1]) + (av[2] * tv[2] + av[3] * tv[3]); }
                  tmpb[e] = acc; }
              __syncthreads();
              for (int e = tid; e < nel; e += 512) { const int blk = e >> 8, i = (e >> 4) & 15, j = e & 15, bi = blk + dd, bj = blk; float acc = 0.f;
#pragma unroll
                  for (int k = 0; k < 16; ++k) acc += TT[(16 * bi + k) * 68 + 16 * bi + i] * tmpb[(blk << 8) + (k << 4) + j];
                  TT[(16 * bj + j) * 68 + 16 * bi + i] = -acc; }
              __syncthreads(); } }
        { const int cc = tid >> 3, part = tid & 7; float tv[8];
#pragma unroll
          for (int e = 0; e < 8; ++e) tv[e] = TT[(part * 8 + e) * 68 + cc];
          u32x4 o; o.x = pk2(tv[0], tv[1]); o.y = pk2(tv[2], tv[3]); o.z = pk2(tv[4], tv[5]); o.w = pk2(tv[6], tv[7]); *(LAS u32x4*)(Tb + cc * 72 + part * 8) = o; }
        __syncthreads();
        { const int mt = wave & 3, ntb = (wave >> 2) * 8;
          const bf16x8 a0 = *(const LAS bf16x8*)(Tb + (16 * mt + r) * 72 + 8 * q), a1 = *(const LAS bf16x8*)(Tb + (16 * mt + r) * 72 + 32 + 8 * q);
#pragma unroll
          for (int i = 0; i < 8; ++i) { const int nt = ntb + i; f32x4 acc = {0.f, 0.f, 0.f, 0.f};
              const bf16x8 b0 = *(const LAS bf16x8*)(rhsT + (16 * nt + r) * 72 + 8 * q), b1 = *(const LAS bf16x8*)(rhsT + (16 * nt + r) * 72 + 32 + 8 * q);
              acc = mfma16(a0, b0, acc); acc = mfma16(a1, b1, acc);
              u32x2 o; o.x = pk2(acc[0], acc[1]); o.y = pk2(acc[2], acc[3]); *(LAS u32x2*)(uwT + (16 * nt + r) * 72 + 16 * mt + 4 * q) = o; } }
        __syncthreads();
        { const bf16x8 k0 = *(const LAS bf16x8*)(kdT + (16 * wave + r) * 72 + 8 * q), k1 = *(const LAS bf16x8*)(kdT + (16 * wave + r) * 72 + 32 + 8 * q);
#pragma unroll
          for (int nt = 0; nt < 8; ++nt) { f32x4 am = {0.f, 0.f, 0.f, 0.f}, an = {0.f, 0.f, 0.f, 0.f};
              const bf16x8 w0 = *(const LAS bf16x8*)(uwT + (128 + 16 * nt + r) * 72 + 8 * q), w1 = *(const LAS bf16x8*)(uwT + (128 + 16 * nt + r) * 72 + 32 + 8 * q);
              const bf16x8 u0 = *(const LAS bf16x8*)(uwT + (16 * nt + r) * 72 + 8 * q), u1 = *(const LAS bf16x8*)(uwT + (16 * nt + r) * 72 + 32 + 8 * q);
              am = mfma16(w0, k0, am); am = mfma16(w1, k1, am); an = mfma16(k0, u0, an); an = mfma16(k1, u1, an);
              u32x2 o; o.x = pk2(-am[0], -am[1]); o.y = pk2(-am[2], -am[3]); *(u32x2*)(Mp + (size_t)task * 16384 + (16 * wave + r) * 128 + 16 * nt + 4 * q) = o;
              o.x = pk2(an[0], an[1]); o.y = pk2(an[2], an[3]); *(u32x2*)(Nl + (size_t)task * 16384 + ((wave * 8 + nt) * 64 + lane) * 4) = o;
              if (nt & 1) asm volatile("" ::: "memory"); }
          const int mt = wave & 3, ntb = (wave >> 2) * 4, tok = 16 * mt + r; const float e = egc[tok];
          const bf16x8 t0 = *(const LAS bf16x8*)(attn + tok * 72 + 8 * q), t1 = *(const LAS bf16x8*)(attn + tok * 72 + 32 + 8 * q);
#pragma unroll
          for (int i = 0; i < 4; ++i) { const int nt = ntb + i; f32x4 aq = {0.f, 0.f, 0.f, 0.f}, ao = {0.f, 0.f, 0.f, 0.f};
              const bf16x8 w0 = *(const LAS bf16x8*)(uwT + (128 + 16 * nt + r) * 72 + 8 * q), w1 = *(const LAS bf16x8*)(uwT + (128 + 16 * nt + r) * 72 + 32 + 8 * q);
              const bf16x8 u0 = *(const LAS bf16x8*)(uwT + (16 * nt + r) * 72 + 8 * q), u1 = *(const LAS bf16x8*)(uwT + (16 * nt + r) * 72 + 32 + 8 * q);
              aq = mfma16(w0, t0, aq); aq = mfma16(w1, t1, aq); ao = mfma16(u0, t0, ao); ao = mfma16(u1, t1, ao);
              const u32x2 qv = *(const LAS u32x2*)(qs + tok * 136 + 16 * nt + 4 * q);
              u32x2 o; o.x = pk2(bflo(qv.x) * e - aq[0], bfhi(qv.x) * e - aq[1]); o.y = pk2(bflo(qv.y) * e - aq[2], bfhi(qv.y) * e - aq[3]);
              *(u32x2*)(Qp + (size_t)task * 8192 + tok * 128 + 16 * nt + 4 * q) = o;
              o.x = pk2(ao[0], ao[1]); o.y = pk2(ao[2], ao[3]); *(u32x2*)(O0 + (size_t)task * 8192 + tok * 128 + 16 * nt + 4 * q) = o; } }
        asm volatile("s_waitcnt lgkmcnt(0)" ::: "memory"); __builtin_amdgcn_s_barrier(); asm volatile("" ::: "memory");
    }
}
template <int NT> struct StepPre { bf16x8 a[4]; u32x2 n[NT]; float gl; };
template <int NT, int MODE> __device__ __forceinline__ void scan_engine(LAS unsigned char* lds, KP kp) {
    LOAD_PARAMS(kp);
    int tid_ = threadIdx.x; asm volatile("" : "+v"(tid_)); const int tid = tid_, lane = tid & 63, t = tid >> 6, r = lane & 15, q = lane >> 4;
    unsigned char* ws = P.ws;
    const bf16* Mseq = (const bf16*)(ws + (MODE == 0 ? WS_MG : WS_MP)); const bf16* Nseq = (const bf16*)(ws + (MODE == 0 ? WS_NG : WS_NL)); const float* glseq = (const float*)(ws + (MODE == 0 ? WS_GG : WS_GL));
    bf16* Simg = (bf16*)(ws + WS_SIMG);
    constexpr int DEPTH = 4, IMG = 16 * NT * 136;
    const int id = bidx();
    int h, colbase, tb0, nsteps, gh = 0, qd = 0;
    if (MODE == 0) { h = id & 3; colbase = 16 * (id >> 2); tb0 = h; nsteps = 16; }
    else { qd = (id >> 3) & 3; gh = (id & 7) | ((id >> 5) << 3); h = gh & 3; const int g = gh >> 2; tb0 = (16 * g) * 4 + h; nsteps = MODE == 1 ? 16 : 15; colbase = MODE == 1 ? 64 * (qd & 1) : 32 * qd; }
    const bool npart = (MODE != 1) || (qd >= 2);
    const int ntile0 = MODE == 0 ? (id >> 2) : (MODE == 1 ? 4 * (qd & 1) : 2 * qd);
    LAS bf16* img = (LAS bf16*)lds;
    f32x4 X[NT]; float gacc = 1.f;
    float dm[NT][4];
#pragma unroll
    for (int n = 0; n < NT; ++n)
#pragma unroll
        for (int j = 0; j < 4; ++j) dm[n][j] = (MODE == 1 && !npart && (16 * t + 4 * q + j) == (colbase + 16 * n + r)) ? 1.f : 0.f;
    if (MODE == 2 && (gh >> 2) > 0) {
#pragma unroll
        for (int n = 0; n < NT; ++n) { const u32x2 v = *(const u32x2*)(Simg + (size_t)tb0 * 16384 + (colbase + 16 * n + r) * 128 + 16 * t + 4 * q);
            X[n] = (f32x4){bflo(v.x), bfhi(v.x), bflo(v.y), bfhi(v.y)}; *(LAS u32x2*)(img + (16 * n + r) * 136 + 16 * t + 4 * q) = v; }
    } else {
#pragma unroll
        for (int n = 0; n < NT; ++n) { X[n] = (f32x4){0.f, 0.f, 0.f, 0.f}; float d[4];
#pragma unroll
            for (int j = 0; j < 4; ++j) d[j] = dm[n][j];
            u32x2 v; v.x = pk2(d[0], d[1]); v.y = pk2(d[2], d[3]); *(LAS u32x2*)(img + (16 * n + r) * 136 + 16 * t + 4 * q) = v;
            if (MODE == 0) *(u32x2*)(Simg + (size_t)h * 16384 + (colbase + 16 * n + r) * 128 + 16 * t + 4 * q) = v; }
    }
    __syncthreads();
    StepPre<NT> ring[DEPTH];
#define SE_LOAD(c_, PR) do { const size_t tb_ = (size_t)(tb0 + 4 * (c_)); const bf16* mp_ = Mseq + tb_ * 16384 + (16 * t + r) * 128 + 8 * q; \
        PR.a[0] = *(const bf16x8*)(mp_); PR.a[1] = *(const bf16x8*)(mp_ + 32); PR.a[2] = *(const bf16x8*)(mp_ + 64); PR.a[3] = *(const bf16x8*)(mp_ + 96); PR.gl = glseq[tb_]; \
        _Pragma("unroll") for (int n_ = 0; n_ < NT; ++n_) { PR.n[n_] = (u32x2){0u, 0u}; if (npart) PR.n[n_] = *(const u32x2*)(Nseq + tb_ * 16384 + ((t * 8 + ntile0 + n_) * 64 + lane) * 4); } } while (0)
#pragma unroll
    for (int i = 0; i < DEPTH; ++i) if (i < nsteps) SE_LOAD(i, ring[i]);
    for (int c0 = 0; c0 < nsteps; c0 += DEPTH) {
#pragma unroll
        for (int i = 0; i < DEPTH; ++i) { const int c = c0 + i;
            if (c < nsteps) { const LAS bf16* im = img + (c & 1) * IMG + r * 136 + 8 * q; LAS bf16* imn = img + ((c + 1) & 1) * IMG + r * 136 + 16 * t + 4 * q;
                const float gl = ring[i].gl; gacc *= gl;
#pragma unroll
                for (int n = 0; n < NT; ++n) { f32x4 a0 = {0.f, 0.f, 0.f, 0.f}, a1 = {0.f, 0.f, 0.f, 0.f};
                    const bf16x8 b0 = *(const LAS bf16x8*)(im + 16 * n * 136), b1 = *(const LAS bf16x8*)(im + 16 * n * 136 + 32), b2 = *(const LAS bf16x8*)(im + 16 * n * 136 + 64), b3 = *(const LAS bf16x8*)(im + 16 * n * 136 + 96);
                    a0 = mfma16(ring[i].a[0], b0, a0); a1 = mfma16(ring[i].a[1], b1, a1); a0 = mfma16(ring[i].a[2], b2, a0); a1 = mfma16(ring[i].a[3], b3, a1);
                    f32x4 x = X[n]; const u32x2 nn = ring[i].n[n];
                    x[0] = gl * x[0] + bflo(nn.x); x[1] = gl * x[1] + bfhi(nn.x); x[2] = gl * x[2] + bflo(nn.y); x[3] = gl * x[3] + bfhi(nn.y); x = x + (a0 + a1); X[n] = x;
                    float d[4];
#pragma unroll
                    for (int j = 0; j < 4; ++j) d[j] = MODE == 1 ? x[j] + dm[n][j] * gacc : x[j];
                    u32x2 o; o.x = pk2(d[0], d[1]); o.y = pk2(d[2], d[3]); *(LAS u32x2*)(imn + 16 * n * 136) = o;
                    if (MODE == 0) *(u32x2*)(Simg + (size_t)((c + 1) * 64 + h) * 16384 + (colbase + 16 * n + r) * 128 + 16 * t + 4 * q) = o;
                    if (MODE == 2) *(u32x2*)(Simg + (size_t)(tb0 + 4 * (c + 1)) * 16384 + (colbase + 16 * n + r) * 128 + 16 * t + 4 * q) = o; }
                if (c + DEPTH < nsteps) SE_LOAD(c + DEPTH, ring[i]);
                asm volatile("s_waitcnt lgkmcnt(0)" ::: "memory"); __builtin_amdgcn_s_barrier(); asm volatile("" ::: "memory"); } } }
#undef SE_LOAD
    if (MODE == 1) {
        if (!npart) { bf16* MG = (bf16*)(ws + WS_MG);
#pragma unroll
            for (int n = 0; n < NT; ++n)
#pragma unroll
                for (int j = 0; j < 4; ++j) MG[(size_t)gh * 16384 + (16 * t + 4 * q + j) * 128 + colbase + 16 * n + r] = (bf16)f2bf(X[n][j]);
        } else { bf16* NG = (bf16*)(ws + WS_NG);
#pragma unroll
            for (int n = 0; n < NT; ++n) { u32x2 o; o.x = pk2(X[n][0], X[n][1]); o.y = pk2(X[n][2], X[n][3]); *(u32x2*)(NG + (size_t)gh * 16384 + ((t * 8 + ntile0 + n) * 64 + lane) * 4) = o; } }
        if (qd == 0 && tid == 0) ((float*)(ws + WS_GG))[gh] = gacc;
    }
    __syncthreads();
}

__device__ __forceinline__ void conformer_phase(LAS unsigned char* lds, int l, KP kp, int first, int step) {
    LOAD_PARAMS(kp);
    int tid_ = threadIdx.x; asm volatile("" : "+v"(tid_)); const int tid = tid_, lane = tid & 63, wave = tid >> 6, ch = tid;
    unsigned char* ws = P.ws; const bf16* proj = (const bf16*)(ws + WS_PROJ); bf16* Y = (bf16*)(ws + WS_Y);
    LAS float* yl = (LAS float*)lds;
    float dw[31];
#pragma unroll
    for (int j = 0; j < 31; ++j) dw[j] = P.in[4][((size_t)l * 31 + j) * 512 + ch];
    const float bias = P.in[5][l * 512 + ch];
    float lw[8], lb[8];
#pragma unroll
    for (int e = 0; e < 8; ++e) { lw[e] = P.in[6][l * 512 + lane + 64 * e]; lb[e] = P.in[7][l * 512 + lane + 64 * e]; }
    for (int ti = first; ti < NCT; ti += step) {
        const int p0 = ti * CT; float win[31];
#pragma unroll
        for (int k = 0; k < 31; ++k) win[k] = 0.f;
        unsigned short rv[2][31], rg[2][31];
#define CF_LOAD(ib_, B_) do { _Pragma("unroll") for (int k = 0; k < 31; ++k) { const int p = p0 - 30 + (ib_) + k; const bf16* pr = proj + (size_t)pos_row(p < 0 ? 0 : (p >= LTOK ? LTOK - 1 : p)) * NPROJ + ch; rv[B_][k] = pr[0]; rg[B_][k] = pr[512]; } } while (0)
        CF_LOAD(0, 0);
#pragma unroll
        for (int b4 = 0; b4 < 4; ++b4) { const int ib = 31 * b4;
            if (b4 == 0) CF_LOAD(31, 1); else if (b4 == 1) CF_LOAD(62, 0); else if (b4 == 2) CF_LOAD(93, 1);
#pragma unroll
            for (int k = 0; k < 31; ++k) { const int i = ib + k, p = p0 - 30 + i, t = i - 30;
                const float v = bf2f(rv[b4 & 1][k]), g = bf2f(rg[b4 & 1][k]); const float uv = (p >= 0 && p < LTOK) ? v * sigm(g) : 0.f;
                win[k] = uv;
                if (t >= 0 && t < CT) { float y = bias;
#pragma unroll
                    for (int j = 0; j < 31; ++j) y += dw[j] * win[(k + 1 + j) % 31];
                    yl[t * 512 + ch] = y; } } }
#undef CF_LOAD
        __syncthreads();
        { float v[9][8], s1[9], s2[9];
#pragma unroll
          for (int tt = 0; tt < 9; ++tt) { const int t = wave * 9 + tt; const bool ok = (t < CT) && (p0 + t < LTOK); s1[tt] = 0.f; s2[tt] = 0.f;
#pragma unroll
              for (int e = 0; e < 8; ++e) { v[tt][e] = ok ? yl[(ok ? t : 0) * 512 + lane + 64 * e] : 0.f; s1[tt] += v[tt][e]; s2[tt] += v[tt][e] * v[tt][e]; } }
#pragma unroll
          for (int off = 1; off < 64; off <<= 1)
#pragma unroll
              for (int tt = 0; tt < 9; ++tt) { s1[tt] += __shfl_xor(s1[tt], off); s2[tt] += __shfl_xor(s2[tt], off); }
#pragma unroll
          for (int tt = 0; tt < 9; ++tt) { const int t = wave * 9 + tt, p = p0 + t;
              if (t < CT && p < LTOK) { const float mean = s1[tt] * (1.f / 512.f), rstd = rsqrtf(fmaxf(s2[tt] * (1.f / 512.f) - mean * mean, 0.f) + 1e-5f);
                  bf16* yr = Y + (size_t)pos_row(p) * DM;
#pragma unroll
                  for (int e = 0; e < 8; ++e) yr[lane + 64 * e] = (bf16)f2bf(silu((v[tt][e] - mean) * rstd * lw[e] + lb[e])); } } }
        __syncthreads();
    }
}
__device__ __forceinline__ void wconv_phase(LAS unsigned char* lds, int l, KP kp) {
    LOAD_PARAMS(kp);
    int tid_ = threadIdx.x; asm volatile("" : "+v"(tid_)); const int tid = tid_, lane = tid & 63, wave = tid >> 6;
    const int gw = (bidx() - NSCAN) * 8 + wave, ngw = (GRID - NSCAN) * 8; LAS float* scr = (LAS float*)(lds + wave * 8448);
    conv_weight_items(1, l, P, scr, gw, ngw, lane); conv_weight_items(2, l, P, scr, gw, ngw, lane); conv_weight_items(3, l, P, scr, gw, ngw, lane);
    if (l + 1 < DEPTH) conv_weight_items(0, l + 1, P, scr, gw, ngw, lane);
}

struct PostBuf { bf16x8 xa[4]; u32x2 o0[4]; u32x2 zv[4]; };
__device__ __forceinline__ void post_phase(LAS unsigned char* lds, int l, KP kp) {
    LOAD_PARAMS(kp);
    int tid_ = threadIdx.x; asm volatile("" : "+v"(tid_)); const int tid = tid_, lane = tid & 63, wave = tid >> 6, r = lane & 15, q = lane >> 4, mt = wave & 3, nh = wave >> 2;
    unsigned char* ws = P.ws;
    const bf16* Qp = (const bf16*)(ws + WS_QP); const bf16* O0 = (const bf16*)(ws + WS_O0); const bf16* Simg = (const bf16*)(ws + WS_SIMG);
    const bf16* proj = (const bf16*)(ws + WS_PROJ); bf16* Y = (bf16*)(ws + WS_Y); const float* nw = P.in[11] + l * 128;
    LAS float* red = (LAS float*)lds;
    const int tok = 16 * mt + r;
    bf16x8 yb[4][4];
    f32x4 wv[4];
#pragma unroll
    for (int n4 = 0; n4 < 4; ++n4) wv[n4] = *(const f32x4*)(nw + 16 * (4 * nh + n4) + 4 * q);
#define POST_LOAD(task_, B) do { const int c_ = (task_) >> 2, h_ = (task_) & 3; const int row_ = chunk_row(c_, tok); \
        _Pragma("unroll") for (int s = 0; s < 4; ++s) B.xa[s] = *(const bf16x8*)(Qp + (size_t)(task_) * 8192 + tok * 128 + 32 * s + 8 * q); \
        _Pragma("unroll") for (int n4 = 0; n4 < 4; ++n4) { const int nt = 4 * nh + n4; \
            B.o0[n4] = *(const u32x2*)(O0 + (size_t)(task_) * 8192 + tok * 128 + 16 * nt + 4 * q); \
            B.zv[n4] = *(const u32x2*)(proj + (size_t)(row_ < 0 ? 0 : row_) * NPROJ + 2560 + h_ * 128 + 16 * nt + 4 * q); } } while (0)
#define POST_LOAD_YB(task_) do { _Pragma("unroll") for (int n4 = 0; n4 < 4; ++n4) _Pragma("unroll") for (int s = 0; s < 4; ++s) \
        yb[n4][s] = *(const bf16x8*)(Simg + (size_t)(task_) * 16384 + (16 * (4 * nh + n4) + r) * 128 + 32 * s + 8 * q); } while (0)
#define POST_COMP(task_, B, par_, next_) do { const int c_ = (task_) >> 2, h_ = (task_) & 3; f32x4 acc[4]; float sq = 0.f; \
        _Pragma("unroll") for (int n4 = 0; n4 < 4; ++n4) { f32x4 a = {0.f, 0.f, 0.f, 0.f}; \
            if (c_ > 0) { _Pragma("unroll") for (int s = 0; s < 4; ++s) a = mfma16(yb[n4][s], B.xa[s], a); } \
            a[0] += bflo(B.o0[n4].x); a[1] += bfhi(B.o0[n4].x); a[2] += bflo(B.o0[n4].y); a[3] += bfhi(B.o0[n4].y); \
            sq += (a[0] * a[0] + a[1] * a[1]) + (a[2] * a[2] + a[3] * a[3]); acc[n4] = a; } \
        if ((next_) >= 4) POST_LOAD_YB(next_);                                    \
        sq += __shfl_xor(sq, 16); sq += __shfl_xor(sq, 32); \
        if (q == 0) red[(par_) * 128 + nh * 64 + tok] = sq; \
        asm volatile("s_waitcnt lgkmcnt(0)" ::: "memory"); __builtin_amdgcn_s_barrier(); asm volatile("" ::: "memory");        \
        const float rstd = rsqrtf((red[(par_) * 128 + tok] + red[(par_) * 128 + 64 + tok]) * (1.f / 128.f) + 1e-6f); \
        const int row = chunk_row(c_, tok); \
        if (row >= 0) { _Pragma("unroll") for (int n4 = 0; n4 < 4; ++n4) { const int dv = 16 * (4 * nh + n4) + 4 * q; const u32x2 zv = B.zv[n4]; const f32x4 w = wv[n4]; const f32x4 a = acc[n4]; \
                u32x2 o; o.x = pk2(a[0] * rstd * w[0] * silu(bflo(zv.x)), a[1] * rstd * w[1] * silu(bfhi(zv.x))); o.y = pk2(a[2] * rstd * w[2] * silu(bflo(zv.y)), a[3] * rstd * w[3] * silu(bfhi(zv.y))); \
                *(u32x2*)(Y + (size_t)row * DM + 512 + h_ * 128 + dv) = o; } } } while (0)
    PostBuf A, Bq; const int t0 = 4 + bidx();
    POST_LOAD(t0, A); POST_LOAD_YB(t0);
    POST_LOAD(t0 + 256, Bq); POST_COMP(t0, A, 0, t0 + 256);
    POST_LOAD(t0 + 512, A); POST_COMP(t0 + 256, Bq, 1, t0 + 512);
    POST_LOAD(t0 + 768, Bq); POST_COMP(t0 + 512, A, 0, t0 + 768);
    if (bidx() < 4) { POST_LOAD(bidx(), A); POST_COMP(t0 + 768, Bq, 1, -1); POST_COMP(bidx(), A, 0, -1); }
    else POST_COMP(t0 + 768, Bq, 1, -1);
#undef POST_LOAD
#undef POST_LOAD_YB
#undef POST_COMP
    __syncthreads();
}

__device__ __forceinline__ void final_phase(KP kp) {
    LOAD_PARAMS(kp);
    const int lane = threadIdx.x & 63, gw = bidx() * 8 + (threadIdx.x >> 6), ngw = GRID * 8; const float* ssq = (const float*)(P.ws + WS_SSQ);
    f32x4 w[4];
#pragma unroll
    for (int j = 0; j < 4; ++j) w[j] = ((const f32x4*)P.in[16])[lane + 64 * j];
    for (int row0 = gw; row0 < SEQ; row0 += 4 * ngw) {
        float sp[4]; f32x4 v[4][4];
#pragma unroll
        for (int i = 0; i < 4; ++i) { const int row = row0 + i * ngw; sp[i] = lane < 16 ? ssq[(size_t)row * 16 + lane] : 0.f;
#pragma unroll
            for (int j = 0; j < 4; ++j) v[i][j] = ((const f32x4*)(P.out + (size_t)row * DM))[lane + 64 * j]; }
#pragma unroll
        for (int i = 0; i < 4; ++i) { const int row = row0 + i * ngw; const float rstd = rsqrtf(wave_sum(sp[i]) * (1.f / 1024.f) + 1e-6f);
#pragma unroll
            for (int j = 0; j < 4; ++j) ((f32x4*)(P.out + (size_t)row * DM))[lane + 64 * j] = v[i][j] * rstd * w[j]; } }
}

template <int KIND, int K> __device__ __forceinline__ void meta_gemm(LAS unsigned char* lds, const bf16* A, const bf16* Bt, int ntask, KP kp, int first, int step) {
    LOAD_PARAMS(kp);
    int tid_ = threadIdx.x; asm volatile("" : "+v"(tid_)); const int tid = tid_, lane = tid & 63, wave = tid >> 6, r = lane & 15, q = lane >> 4;
    constexpr int NT = KIND == 1 ? 4 : (KIND == 2 ? 2 : 1);
    unsigned char* ws = P.ws; float* ssq = (float*)(ws + WS_SSQ);
    LAS f32x4* part = (LAS f32x4*)lds;
    LAS float* sqx = (LAS float*)(lds + 65536);
    constexpr int kw = K >> 3, NSTEP = kw / 32; const int k0 = wave * kw;
    const bf16* arow = A + (size_t)(SEQ + r) * K + k0 + 8 * q;
    for (int task = first; task < ntask; task += step) {
        f32x4 acc[NT];
        const bf16* brow[NT];
#pragma unroll
        for (int n = 0; n < NT; ++n) { acc[n] = (f32x4){0.f, 0.f, 0.f, 0.f};
            int brw; if (KIND == 0) brw = 16 * task + r; else if (KIND == 1) brw = 64 * task + 16 * n + r; else brw = 256 * (task >> 3) + 128 * n + 16 * (task & 7) + r;
            brow[n] = Bt + (size_t)brw * K + k0 + 8 * q; }
#pragma unroll
        for (int s0 = 0; s0 < NSTEP; s0 += 4) { bf16x8 af[4], bfm[NT][4];
#pragma unroll
            for (int i = 0; i < 4; ++i) if (s0 + i < NSTEP) { af[i] = *(const bf16x8*)(arow + 32 * (s0 + i));
#pragma unroll
                for (int n = 0; n < NT; ++n) bfm[n][i] = *(const bf16x8*)(brow[n] + 32 * (s0 + i)); }
#pragma unroll
            for (int i = 0; i < 4; ++i) if (s0 + i < NSTEP) {
#pragma unroll
                for (int n = 0; n < NT; ++n) acc[n] = mfma16(af[i], bfm[n][i], acc[n]); } }
#pragma unroll
        for (int n = 0; n < NT; ++n) part[(wave * NT + n) * 64 + lane] = acc[n];
        __syncthreads();
        if (wave < (KIND == 1 ? 4 : 1)) { const int n0 = KIND == 1 ? wave : 0;
            f32x4 v[KIND == 2 ? 2 : 1];
#pragma unroll
            for (int n = 0; n < (KIND == 2 ? 2 : 1); ++n) { f32x4 t = part[(0 * NT + n0 + n) * 64 + lane];
#pragma unroll
                for (int w = 1; w < 8; ++w) t = t + part[(w * NT + n0 + n) * 64 + lane];
                v[n] = t; }
            if (KIND == 0 || KIND == 2) { float rs_[4];
#pragma unroll
                for (int j = 0; j < 4; ++j) { const f32x4* p = (const f32x4*)(ssq + (size_t)(SEQ + 4 * q + j) * 16); const f32x4 a = p[0], b = p[1], c = p[2], d = p[3];
                    rs_[j] = rsqrtf((((a[0] + a[1]) + (a[2] + a[3])) + ((b[0] + b[1]) + (b[2] + b[3])) + ((c[0] + c[1]) + (c[2] + c[3])) + ((d[0] + d[1]) + (d[2] + d[3]))) * (1.f / 1024.f) + 1e-6f); }
                if (KIND == 0) { bf16* proj = (bf16*)(ws + WS_PROJ);
#pragma unroll
                    for (int j = 0; j < 4; ++j) proj[(size_t)(SEQ + 4 * q + j) * NPROJ + 16 * task + r] = (bf16)f2bf(v[0][j] * rs_[j]);
                } else { bf16* act = (bf16*)(ws + WS_PROJ);
#pragma unroll
                    for (int j = 0; j < 4; ++j) { const float g = v[0][j] * rs_[j], up = v[KIND == 2 ? 1 : 0][j] * rs_[j]; act[(size_t)(SEQ + 4 * q + j) * DFF + 128 * (task >> 3) + 16 * (task & 7) + r] = (bf16)f2bf(silu(g) * up); } }
            } else { float* hmeta = (float*)(ws + WS_HMETA); bf16* hb = (bf16*)(ws + WS_HB); const int col = 64 * task + 16 * n0 + r;
#pragma unroll
                for (int j = 0; j < 4; ++j) { const int row = 4 * q + j; float hv = hmeta[(size_t)row * DM + col] + v[0][j]; hmeta[(size_t)row * DM + col] = hv; hb[(size_t)(SEQ + row) * DM + col] = (bf16)f2bf(hv);
                    float sq = hv * hv; sq += __shfl_xor(sq, 1); sq += __shfl_xor(sq, 2); sq += __shfl_xor(sq, 4); sq += __shfl_xor(sq, 8);
                    if (r == 0) sqx[n0 * 16 + row] = sq; } }
        }
        __syncthreads();
        if (KIND == 1 && tid < 16) ssq[(size_t)(SEQ + tid) * 16 + task] = (sqx[tid] + sqx[16 + tid]) + (sqx[32 + tid] + sqx[48 + tid]);
        if (KIND == 1) __syncthreads();
    }
}

__device__ __forceinline__ void gates_phase(LAS unsigned char* lds, int l, KP kp) {
    LOAD_PARAMS(kp);
    int tid_ = threadIdx.x; asm volatile("" : "+v"(tid_)); const int tid = tid_, lane = tid & 63, wave = tid >> 6, r = lane & 15, q = lane >> 4;
    unsigned char* ws = P.ws; const bf16* hb = (const bf16*)(ws + WS_HB); const float* ssq = (const float*)(ws + WS_SSQ); const bf16* wb = (const bf16*)(ws + WS_WBAB) + (size_t)l * 16 * DM; float* bg = (float*)(ws + WS_BG);
    LAS f32x4* part = (LAS f32x4*)lds;
    const int k0 = 128 * wave;
    bf16x8 b[4]; bf16x8 a[5][4];
    f32x4 sv[4][4];
    { const int tile = min(bidx() + 256 * (wave < 5 ? wave : 0), 1024);
#pragma unroll
      for (int j = 0; j < 4; ++j) { const f32x4* p = (const f32x4*)(ssq + (size_t)(16 * tile + 4 * q + j) * 16); sv[j][0] = p[0]; sv[j][1] = p[1]; sv[j][2] = p[2]; sv[j][3] = p[3]; } }
#pragma unroll
    for (int s = 0; s < 4; ++s) b[s] = *(const bf16x8*)(wb + (size_t)r * DM + k0 + 32 * s + 8 * q);
#pragma unroll
    for (int j = 0; j < 5; ++j) { const int tile = min(bidx() + 256 * j, 1024);
#pragma unroll
        for (int s = 0; s < 4; ++s) a[j][s] = *(const bf16x8*)(hb + (size_t)(16 * tile + r) * DM + k0 + 32 * s + 8 * q); }
#pragma unroll
    for (int j = 0; j < 5; ++j) { f32x4 acc = {0.f, 0.f, 0.f, 0.f};
#pragma unroll
        for (int s = 0; s < 4; ++s) acc = mfma16(a[j][s], b[s], acc);
        part[(j * 8 + wave) * 64 + lane] = acc; }
    __syncthreads();
    if (wave < 5) { const int tile = bidx() + 256 * wave;
        f32x4 v = part[(wave * 8) * 64 + lane];
#pragma unroll
        for (int w = 1; w < 8; ++w) v = v + part[(wave * 8 + w) * 64 + lane];
#pragma unroll
        for (int j = 0; j < 4; ++j) v[j] += __shfl_xor(v[j], 8);
        if (tile < 1025 && r < 8) {
            const int hh = r & 3; const float nalog = -__expf(P.in[9][l * 4 + hh]), dtb = P.in[10][l * 4 + hh];
#pragma unroll
            for (int j = 0; j < 4; ++j) { const int row = 16 * tile + 4 * q + j; const f32x4 s0 = sv[j][0], s1 = sv[j][1], s2 = sv[j][2], s3 = sv[j][3];
                const float rstd = rsqrtf((((s0[0] + s0[1]) + (s0[2] + s0[3])) + ((s1[0] + s1[1]) + (s1[2] + s1[3])) + ((s2[0] + s2[1]) + (s2[2] + s2[3])) + ((s3[0] + s3[1]) + (s3[2] + s3[3]))) * (1.f / 1024.f) + 1e-6f);
                const float x = v[j] * rstd; float out;
                if (r < 4) out = 1.f / (1.f + __expf(-x)); else { const float av = x + dtb; out = nalog * (av > 20.f ? av : __logf(1.f + __expf(av))); }
                bg[(size_t)row * 8 + r] = out; } } }
    __syncthreads();
}

#define XB_TMO      128
#define XB_XCNT(j)  (256  + 64 * (j))
#define XB_XSUB(j)  (1280 + 64 * (j))
#define XB_XGEN(j)  (2304 + 64 * (j))
#define XB_TOP      3328
#define XB_TOPGEN   3392
#define XCD_BAR_WORDS 3456
#define XB_SPIN_CAP (1u << 18)

__device__ __forceinline__ unsigned xb_ld(unsigned* p)              { return __hip_atomic_load(p, __ATOMIC_RELAXED, __HIP_MEMORY_SCOPE_AGENT); }
__device__ __forceinline__ unsigned xb_add(unsigned* p, unsigned v) { return __hip_atomic_fetch_add(p, v, __ATOMIC_RELAXED, __HIP_MEMORY_SCOPE_AGENT); }
__device__ __forceinline__ unsigned xb_xcc_id() { return (unsigned)__builtin_amdgcn_s_getreg((3 << 11) | 20) & 0xFu; }
#define XB_SPIN(cond, bar) do { unsigned _sp = 0; while (cond) { __builtin_amdgcn_s_sleep(1); \
    if ((++_sp & 255u) == 0u) { if (xb_ld(&(bar)[XB_TMO])) break; if (_sp > XB_SPIN_CAP) { atomicAdd(&(bar)[XB_TMO], 1u); break; } } } } while (0)

struct XcdBarrier {
    unsigned* bar; unsigned x;
    volatile LAS unsigned* st;
};

__device__ __forceinline__ XcdBarrier xcd_barrier_post(unsigned* bar, volatile LAS unsigned* st) {
    XcdBarrier b; b.bar = bar; b.x = xb_xcc_id(); b.st = st;
    if (threadIdx.x == 0) (void)xb_add(&bar[XB_XCNT(b.x)], 1u);
    return b;
}
__device__ __forceinline__ void xcd_barrier_complete(unsigned* bar, unsigned x, unsigned& nloc, unsigned& nx) {
    const unsigned G = gridDim.x * gridDim.y * gridDim.z;
    unsigned sum, cnt, mine, sp = 0u;
    for (;;) {
        sum = 0u; cnt = 0u; mine = 0u;
#pragma unroll
        for (unsigned j = 0; j < 16; ++j) { const unsigned c = xb_ld(&bar[XB_XCNT(j)]); sum += c; cnt += (c > 0u) ? 1u : 0u; mine = (j == x) ? c : mine; }
        if (sum == G) break;
        __builtin_amdgcn_s_sleep(1);
        if ((++sp & 255u) == 0u) { if (xb_ld(&bar[XB_TMO])) break; if (sp > XB_SPIN_CAP) { atomicAdd(&bar[XB_TMO], 1u); break; } }
    }
    nloc = mine > 0u ? mine : 1u; nx = cnt > 0u ? cnt : 1u;
}

__device__ __forceinline__ void xcd_barrier(const XcdBarrier& b) {
    asm volatile("s_waitcnt vmcnt(0)" ::: "memory");
    __syncthreads();
    if (threadIdx.x == 0) {
        unsigned* bar = b.bar;
        __builtin_amdgcn_s_waitcnt(0);
        unsigned nloc = b.st[0], nx = b.st[1];
        if (nloc == 0u) { xcd_barrier_complete(bar, b.x, nloc, nx); b.st[0] = nloc; b.st[1] = nx; }
        const unsigned old = xb_add(&bar[XB_XSUB(b.x)], 1u);
        const unsigned gen = old / nloc;
        if (old + 1u == (gen + 1u) * nloc) {
            __builtin_amdgcn_fence(__ATOMIC_RELEASE, "agent");
            asm volatile("s_waitcnt vmcnt(0)" ::: "memory");
            const unsigned og = xb_add(&bar[XB_TOP], 1u);
            const unsigned tg = og / nx;
            if (og + 1u == (tg + 1u) * nx) xb_add(&bar[XB_TOPGEN], 1u);
            else XB_SPIN(xb_ld(&bar[XB_TOPGEN]) == tg, bar);
            __builtin_amdgcn_fence(__ATOMIC_ACQUIRE, "agent");
            xb_add(&bar[XB_XGEN(b.x)], 1u);
            asm volatile("s_waitcnt vmcnt(0)" ::: "memory");
        } else {
            XB_SPIN(xb_ld(&bar[XB_XGEN(b.x)]) == gen, bar);
            __builtin_amdgcn_fence(__ATOMIC_ACQUIRE, "agent");
            asm volatile("s_waitcnt vmcnt(0)" ::: "memory");
        }
    }
    __syncthreads();
}

__global__ void __launch_bounds__(512, 2) fwd_megakernel(Params Pk) {
    extern __shared__ __attribute__((aligned(16))) unsigned char lds_raw[];
    LAS unsigned char* lds = (LAS unsigned char*)lds_raw;
    cg::grid_group grid = cg::this_grid();
    KP kp = (KP)__builtin_amdgcn_kernarg_segment_ptr();
    LAS float* rs = (LAS float*)(lds + RS_OFF);
    volatile LAS unsigned* bst = (volatile LAS unsigned*)(lds + 147440);
    if (threadIdx.x < 2) bst[threadIdx.x] = 0u;
    __syncthreads();
    { LOAD_PARAMS(kp); (void)xcd_barrier_post((unsigned*)P.ws, bst); }
#define GRID_SYNC() do { LOAD_PARAMS(kp); XcdBarrier xb_; xb_.bar = (unsigned*)P.ws; xb_.x = xb_xcc_id(); xb_.st = (volatile LAS unsigned*)(lds + 147440); xcd_barrier(xb_); } while (0)
    prologue_phase(lds, kp);
    { LOAD_PARAMS(kp); if (P.ws == nullptr) grid.sync(); }
    GRID_SYNC();
    for (int l = 0; l < DEPTH; ++l) {
        { LOAD_PARAMS(kp); unsigned char* ws = P.ws; meta_gemm<0, DM>(lds, (const bf16*)(ws + WS_HB), (const bf16*)(ws + WS_WIN), NPROJ / 16, kp, bidx(), 256);
          pg8::Gemm g{(const bf16*)(ws + WS_HB), (const bf16*)(ws + WS_WIN), SEQ, NPROJ, DM}; pg8::StaticOrder S; S.init(SEQ, NPROJ, GRID, bidx()); fill_rstd(rs, S, (const float*)(ws + WS_SSQ));
          pg8::EpiProj E{(bf16*)(ws + WS_PROJ), NPROJ, rs}; pg8::gemm_phase<pg8::EpiProj, pg8::StaticOrder, true, true>(lds, g, S, E); }
        gates_phase(lds, l, kp);
        GRID_SYNC();
        prep_phase(lds, l, kp);
        { int bid = bidx(); asm volatile("" : "+s"(bid)); if (bid >= 4) { asm volatile("s_waitcnt lgkmcnt(0)" ::: "memory"); __builtin_amdgcn_s_barrier(); asm volatile("" ::: "memory");   conformer_phase(lds, l, kp, bid - 4, 252); } }
        GRID_SYNC();
        scan_engine<4, 1>(lds, kp);
        GRID_SYNC();
        if (bidx() < NSCAN) scan_engine<1, 0>(lds, kp); else wconv_phase(lds, l, kp);
        GRID_SYNC();
        scan_engine<2, 2>(lds, kp);
        GRID_SYNC();
        post_phase(lds, l, kp);
        GRID_SYNC();
        { LOAD_PARAMS(kp); unsigned char* ws = P.ws; meta_gemm<1, DM>(lds, (const bf16*)(ws + WS_Y), (const bf16*)(ws + WS_WOUT), 16, kp, bidx(), 256);
          pg8::Gemm g{(const bf16*)(ws + WS_Y), (const bf16*)(ws + WS_WOUT), SEQ, DM, DM}; pg8::StaticOrder S; S.init(SEQ, DM, GRID, bidx());
          pg8::EpiResid E{P.out, (float*)(ws + WS_HMETA), (bf16*)(ws + WS_HB), (float*)(ws + WS_SSQ)}; pg8::gemm_phase<pg8::EpiResid, pg8::StaticOrder, true, true>(lds, g, S, E); }
        GRID_SYNC();
        { LOAD_PARAMS(kp); unsigned char* ws = P.ws; if (bidx() >= 128) meta_gemm<2, DM>(lds, (const bf16*)(ws + WS_HB), (const bf16*)(ws + WS_WGU), 176, kp, bidx() - 128, 128);
          pg8::Gemm g{(const bf16*)(ws + WS_HB), (const bf16*)(ws + WS_WGU), SEQ, NGU, DM}; pg8::StaticOrder S; S.init(SEQ, NGU, GRID, bidx()); fill_rstd(rs, S, (const float*)(ws + WS_SSQ));
          pg8::EpiSwiGLU E{(bf16*)(ws + WS_PROJ)  , DFF, rs}; pg8::gemm_phase<pg8::EpiSwiGLU, pg8::StaticOrder, true, true>(lds, g, S, E); }
        GRID_SYNC();
        { LOAD_PARAMS(kp); unsigned char* ws = P.ws; meta_gemm<1, DFF>(lds, (const bf16*)(ws + WS_PROJ), (const bf16*)(ws + WS_WDN), 16, kp, bidx(), 256);
          pg8::Gemm g{(const bf16*)(ws + WS_PROJ), (const bf16*)(ws + WS_WDN), SEQ, DM, DFF}; pg8::StaticOrder S; S.init(SEQ, DM, GRID, bidx());
          pg8::EpiResid E{P.out, (float*)(ws + WS_HMETA), (bf16*)(ws + WS_HB), (float*)(ws + WS_SSQ)}; pg8::gemm_phase<pg8::EpiResid, pg8::StaticOrder, true, true>(lds, g, S, E); }
        GRID_SYNC();
    }
    final_phase(kp);
}

extern "C" void kernel_launch(void* const* d_in, const int* in_sizes, int n_in, void* d_out, int out_size, void* d_ws, size_t ws_size, hipStream_t stream) {
    static int grid = 0;
    if (grid == 0) {
        if (n_in != 17 || out_size != SEQ * DM || ws_size < WS_END) { fprintf(stderr, "kernel_launch: unexpected shapes (n_in %d, out %d, ws %zu)\n", n_in, out_size, ws_size); grid = -1; return; }
        int dev = 0, cus = 0, per_cu = 0;
        hipGetDevice(&dev); hipDeviceGetAttribute(&cus, hipDeviceAttributeMultiprocessorCount, dev);
        if (hipFuncSetAttribute((const void*)fwd_megakernel, hipFuncAttributeMaxDynamicSharedMemorySize, LDS_BYTES) != hipSuccess) { fprintf(stderr, "kernel_launch: hipFuncSetAttribute failed\n"); grid = -1; return; }
        hipOccupancyMaxActiveBlocksPerMultiprocessor(&per_cu, (const void*)fwd_megakernel, 512, LDS_BYTES);
        (void)hipGetLastError();
        if (per_cu < 1) { fprintf(stderr, "kernel_launch: occupancy query says %d blocks per CU\n", per_cu); per_cu = 1; }
        grid = 256;
        if (cus < 256) { fprintf(stderr, "kernel_launch: needs 256 CUs, device has %d\n", cus); grid = -1; return; }
    }
    if (grid < 0) return;
    if (hipMemsetAsync(d_ws, 0, 16384, stream) != hipSuccess) { fprintf(stderr, "kernel_launch: memset of the barrier words failed\n"); return; }
    Params p{};
    for (int i = 0; i < 17; ++i) p.in[i] = (const float*)d_in[i];
    p.out = (float*)d_out; p.ws = (unsigned char*)d_ws;
    void* args[] = {&p};
    hipError_t e = hipLaunchCooperativeKernel((const void*)fwd_megakernel, dim3(grid), dim3(512), args, LDS_BYTES, stream);
    if (e != hipSuccess) fprintf(stderr, "cooperative launch failed: %s (grid %d)\n", hipGetErrorString(e), grid);
}
```
